# Optimizing an MI355X kernel written in HIP

```python
import math
import jax, jax.numpy as jnp
from jax import lax
import numpy as np

D_MODEL = 1024
BATCH = 8
SEQ = 4096
DEPTH = 1

HEAD_DIM = 64
FOX_HEADS = 8
DIL_HEADS = 8
FOX_W = FOX_HEADS * HEAD_DIM
DIL_W = DIL_HEADS * HEAD_DIM
Q_BLOCK = 128
DILATED_PATTERNS = ((128, 1), (512, 4), (2048, 16))
ROPE_THETA = 500000.0
ROT_DIM = HEAD_DIM // 4
N_GROUPS = 4
EXPERTS_PER_GROUP = 8
N_EXPERTS = N_GROUPS * EXPERTS_PER_GROUP
TOP_K = 2
D_EXPERT = 512
MOE_BLOCK = 256
LN_EPS = 1e-5
NEG = -1e30
DEEPNORM_ALPHA = (2 * DEPTH) ** 0.25
DEEPNORM_BETA = (8 * DEPTH) ** (-0.25)
PROJ_SIZES = (FOX_W, FOX_W, FOX_W, FOX_W, FOX_HEADS, DIL_W, DIL_W, DIL_W)
PROJ_COLS = sum(PROJ_SIZES)

kernel_name = "hybrid_fox_dilated_hmoe_deepnorm_layer"


def layer_norm(x, g, b):
    xf = x.astype(jnp.float32)
    mu = jnp.mean(xf, axis=-1, keepdims=True)
    var = jnp.mean(jnp.square(xf - mu), axis=-1, keepdims=True)
    return ((xf - mu) * lax.rsqrt(var + LN_EPS) * g + b).astype(x.dtype)


def partial_rope(t, positions):
    half = ROT_DIM // 2
    inv_freq = ROPE_THETA ** (-jnp.arange(0, ROT_DIM, 2, dtype=jnp.float32) / ROT_DIM)
    ang = positions.astype(jnp.float32)[..., None] * inv_freq
    cos, sin = jnp.cos(ang)[:, :, None, :], jnp.sin(ang)[:, :, None, :]
    tf = t.astype(jnp.float32)
    x1, x2, rest = tf[..., :half], tf[..., half:ROT_DIM], tf[..., ROT_DIM:]
    out = jnp.concatenate([x1 * cos - x2 * sin, x2 * cos + x1 * sin, rest], axis=-1)
    return out.astype(t.dtype)


def forgetting_attention(q, k, v, log_f):
    B, H, S, hd = q.shape
    nb = S // Q_BLOCK
    cum = jnp.cumsum(log_f, axis=-1)
    qb = q.reshape(B, H, nb, Q_BLOCK, hd).transpose(2, 0, 1, 3, 4)
    cb = cum.reshape(B, H, nb, Q_BLOCK).transpose(2, 0, 1, 3)
    kpos = jnp.arange(S)
    scale = HEAD_DIM ** -0.5

    def block(args):
        qi, ci, n = args
        s = jnp.einsum('bhqd,bhkd->bhqk', qi, k) * scale + ci[..., :, None] - cum[:, :, None, :]
        qpos = n * Q_BLOCK + jnp.arange(Q_BLOCK)
        s = jnp.where(kpos[None, :] <= qpos[:, None], s, NEG)
        p = jax.nn.softmax(s, axis=-1)
        return jnp.einsum('bhqk,bhkd->bhqd', p, v)

    o = lax.map(block, (qb, cb, jnp.arange(nb)))
    return o.transpose(1, 2, 0, 3, 4).reshape(B, H, S, hd)


def dilated_window_attention(q, k, v, window, dilation):
    B, H, S, hd = q.shape
    w = window // dilation
    unit = dilation * w
    Sp = -(-S // unit) * unit
    L = Sp // dilation
    nb = L // w
    pad = ((0, 0), (0, 0), (0, Sp - S), (0, 0))

    def to_res(a):
        a = jnp.pad(a, pad).reshape(B, H, L, dilation, hd).transpose(0, 1, 3, 2, 4)
        return a.reshape(B, H, dilation, nb, w, hd)

    def with_prev(a):
        prev = jnp.pad(a, ((0, 0), (0, 0), (0, 0), (1, 0), (0, 0), (0, 0)))[:, :, :, :nb]
        return jnp.concatenate([prev, a], axis=4)

    qr = to_res(q)
    kr = with_prev(to_res(k))
    vr = with_prev(to_res(v))
    s = jnp.einsum('bhrnqd,bhrnkd->bhrnqk', qr, kr) * (HEAD_DIM ** -0.5)
    n_i = jnp.arange(nb)[:, None, None]
    i_i = jnp.arange(w)[None, :, None]
    j_i = jnp.arange(2 * w)[None, None, :]
    valid = (j_i >= i_i) & (j_i <= i_i + w) & ((n_i > 0) | (j_i >= w))
    s = jnp.where(valid, s, NEG)
    lse = jax.nn.logsumexp(s, axis=-1)
    p = jnp.exp(s - lse[..., None])
    o = jnp.einsum('bhrnqk,bhrnkd->bhrnqd', p, vr)
    o = o.reshape(B, H, dilation, L, hd).transpose(0, 1, 3, 2, 4).reshape(B, H, Sp, hd)[:, :, :S]
    lse = lse.reshape(B, H, dilation, L).transpose(0, 1, 3, 2).reshape(B, H, Sp)[:, :, :S]
    return o, lse


def mixing_sublayer(h, positions, w_in, b_forget, w_out):
    B, S, _ = h.shape
    proj = h @ w_in
    splits = list(np.cumsum(PROJ_SIZES)[:-1])
    fq, fk, fv, fog, ff, dq, dk, dv = jnp.split(proj, splits, axis=-1)

    def heads(t, n):
        return t.reshape(B, S, n, HEAD_DIM)

    def bhsd(t):
        return t.transpose(0, 2, 1, 3).astype(jnp.float32)

    log_f = jax.nn.log_sigmoid(ff.astype(jnp.float32) + b_forget).transpose(0, 2, 1)
    fox = forgetting_attention(bhsd(heads(fq, FOX_HEADS)), bhsd(heads(fk, FOX_HEADS)),
                               bhsd(heads(fv, FOX_HEADS)), log_f)
    fox = fox.transpose(0, 2, 1, 3).reshape(B, S, FOX_W) * jax.nn.sigmoid(fog.astype(jnp.float32))

    dqh = bhsd(partial_rope(heads(dq, DIL_HEADS), positions))
    dkh = bhsd(partial_rope(heads(dk, DIL_HEADS), positions))
    dvh = bhsd(heads(dv, DIL_HEADS))
    outs, lses = [], []
    for window, dilation in DILATED_PATTERNS:
        o, l = dilated_window_attention(dqh, dkh, dvh, window, dilation)
        outs.append(o)
        lses.append(l)
    wts = jax.nn.softmax(jnp.stack(lses, axis=0), axis=0)
    dil = jnp.sum(wts[..., None] * jnp.stack(outs, axis=0), axis=0)
    dil = dil.transpose(0, 2, 1, 3).reshape(B, S, DIL_W)

    merged = jnp.concatenate([fox, dil], axis=-1).astype(h.dtype)
    return merged @ w_out


def hierarchical_moe(h, w_rg, b_rg, w_re, b_re, w_up, w_gate, w_down):
    N, D = h.shape
    gl = (h @ w_rg).astype(jnp.float32) + b_rg
    g = jnp.argmax(gl, axis=-1)
    p_g = jnp.take_along_axis(jax.nn.softmax(gl, axis=-1), g[:, None], axis=-1)[:, 0]
    el = ((h @ w_re).astype(jnp.float32) + b_re).reshape(N, N_GROUPS, EXPERTS_PER_GROUP)
    el_g = jnp.take_along_axis(el, g[:, None, None], axis=1)[:, 0]
    top_v, top_i = lax.top_k(el_g, TOP_K)
    top_w = jax.nn.softmax(top_v, axis=-1) * p_g[:, None]

    A = N * TOP_K
    eid = (g[:, None] * EXPERTS_PER_GROUP + top_i).reshape(A).astype(jnp.int32)
    tok = jnp.repeat(jnp.arange(N, dtype=jnp.int32), TOP_K)
    wgt = top_w.reshape(A)
    order = jnp.argsort(eid)
    s_eid, s_tok, s_w = eid[order], tok[order], wgt[order]
    counts = jnp.bincount(eid, length=N_EXPERTS)
    pcounts = (counts + MOE_BLOCK - 1) // MOE_BLOCK * MOE_BLOCK
    offs = jnp.cumsum(counts) - counts
    pend = jnp.cumsum(pcounts)
    poffs = pend - pcounts
    dest = poffs[s_eid] + (jnp.arange(A) - offs[s_eid])
    nblk = -(-A // MOE_BLOCK) + N_EXPERTS
    P = nblk * MOE_BLOCK
    row_tok = jnp.full((P,), N, dtype=jnp.int32).at[dest].set(s_tok)
    row_w = jnp.zeros((P,), dtype=h.dtype).at[dest].set(s_w.astype(h.dtype))
    blk_e = jnp.minimum(jnp.searchsorted(pend, jnp.arange(nblk) * MOE_BLOCK, side='right'),
                        N_EXPERTS - 1)
    xr = h[jnp.minimum(row_tok, N - 1)].reshape(nblk, MOE_BLOCK, D)

    def expert_block(args):
        xb, e = args
        return (jax.nn.silu(xb @ w_gate[e]) * (xb @ w_up[e])) @ w_down[e]

    yr = lax.map(expert_block, (xr, blk_e)).reshape(P, D)
    return jax.ops.segment_sum(yr * row_w[:, None], row_tok, num_segments=N)


def setup_inputs(seed: int = 0) -> dict:
    key = jax.random.key(seed)
    ks = jax.random.split(key, 20)
    D = D_MODEL
    f32 = jnp.float32
    x = jax.random.normal(ks[0], (BATCH, SEQ, D), f32)
    c = jax.random.normal(ks[1], (BATCH, D), f32)
    positions = (jax.random.randint(ks[2], (BATCH, 1), 0, 2048)
                 + jnp.arange(SEQ)[None, :]).astype(jnp.int32)
    w_ada = jax.random.normal(ks[3], (D, 6 * D), f32) * (0.5 * D ** -0.5)
    b_ada = jax.random.normal(ks[4], (6 * D,), f32) * 0.01
    col_scale = np.ones((PROJ_COLS,), np.float32)
    bounds = np.concatenate([[0], np.cumsum(PROJ_SIZES)])
    for idx in (2, 7):
        col_scale[bounds[idx]:bounds[idx + 1]] = DEEPNORM_BETA
    w_in = jax.random.normal(ks[5], (D, PROJ_COLS), f32) * (D ** -0.5) * jnp.asarray(col_scale)
    b_forget = 2.0 + 4.0 * jax.random.uniform(ks[6], (FOX_HEADS,), f32)
    w_out = jax.random.normal(ks[7], (D, D), f32) * (D ** -0.5) * DEEPNORM_BETA
    ln1_g = 1.0 + 0.01 * jax.random.normal(ks[8], (D,), f32)
    ln1_b = 0.01 * jax.random.normal(ks[9], (D,), f32)
    w_router_group = jax.random.normal(ks[10], (D, N_GROUPS), f32) * (D ** -0.5)
    b_router_group = 0.01 * jax.random.normal(ks[11], (N_GROUPS,), f32)
    w_router_expert = jax.random.normal(ks[12], (D, N_EXPERTS), f32) * (D ** -0.5)
    b_router_expert = 0.01 * jax.random.normal(ks[13], (N_EXPERTS,), f32)
    w_up = jax.random.normal(ks[14], (N_EXPERTS, D, D_EXPERT), f32) * (D ** -0.5)
    w_gate = jax.random.normal(ks[15], (N_EXPERTS, D, D_EXPERT), f32) * (D ** -0.5)
    w_down = jax.random.normal(ks[16], (N_EXPERTS, D_EXPERT, D), f32) * (D_EXPERT ** -0.5) * DEEPNORM_BETA
    ln2_g = 1.0 + 0.01 * jax.random.normal(ks[17], (D,), f32)
    ln2_b = 0.01 * jax.random.normal(ks[18], (D,), f32)
    return {"x": x, "c": c, "positions": positions, "w_ada": w_ada, "b_ada": b_ada,
            "w_in": w_in, "b_forget": b_forget, "w_out": w_out, "ln1_g": ln1_g, "ln1_b": ln1_b,
            "w_router_group": w_router_group, "b_router_group": b_router_group,
            "w_router_expert": w_router_expert, "b_router_expert": b_router_expert,
            "w_up": w_up, "w_gate": w_gate, "w_down": w_down, "ln2_g": ln2_g, "ln2_b": ln2_b}


def reference(x, c, positions, w_ada, b_ada, w_in, b_forget, w_out, ln1_g, ln1_b,
              w_router_group, b_router_group, w_router_expert, b_router_expert,
              w_up, w_gate, w_down, ln2_g, ln2_b):
    B, S, D = x.shape
    mod = jax.nn.silu(c) @ w_ada + b_ada
    shift1, scale1, gate1, shift2, scale2, gate2 = jnp.split(mod, 6, axis=-1)
    for _ in range(DEPTH):
        h = x * (1.0 + scale1[:, None, :]) + shift1[:, None, :]
        y = mixing_sublayer(h, positions, w_in, b_forget, w_out)
        x = layer_norm(DEEPNORM_ALPHA * x + gate1[:, None, :] * y, ln1_g, ln1_b)
        h = x * (1.0 + scale2[:, None, :]) + shift2[:, None, :]
        y = hierarchical_moe(h.reshape(B * S, D), w_router_group, b_router_group,
                             w_router_expert, b_router_expert, w_up, w_gate, w_down).reshape(B, S, D)
        x = layer_norm(DEEPNORM_ALPHA * x + gate2[:, None, :] * y, ln2_g, ln2_b)
    return x
```

```cpp
#include <hip/hip_runtime.h>
#include <stdint.h>

namespace cfg {
constexpr int B = 8, S = 4096, D = 1024, M = B * S, NH = 8, HD = 64, GW = 512;
constexpr int PROJ_LD = 3592, NPROJ = 3584;
constexpr int NE = 32, EPG = 8, NG = 4, DE = 512, MOEB = 256;
constexpr int PROWS = 2 * M + NE * MOEB;
constexpr float LN_EPS = 1e-5f;
constexpr float ALPHA = 1.189207115002721f;
constexpr float LOG2E = 1.4426950408889634f;
constexpr float C2 = 0.125f * 1.4426950408889634f;
constexpr size_t MiB = 1u << 20;
constexpr size_t WS_CTL = 0, WS_MOD = 1 * MiB, WS_CNT = 2 * MiB, WS_CS = 3 * MiB, WS_CB = 5 * MiB, WS_LOGF = 6 * MiB;
constexpr size_t WS_TOPE = 7 * MiB, WS_TOPW = 7 * MiB + 256 * 1024, WS_SLOT = 7 * MiB + 512 * 1024;
constexpr size_t WS_ROWTOK = 8 * MiB, WS_ROWW = 8 * MiB + 512 * 1024;
constexpr size_t WS_LSE1 = 9 * MiB, WS_LSE4 = 10 * MiB;
constexpr size_t WS_WIN = 16 * MiB, WS_WOUT = 23 * MiB, WS_WGU = 25 * MiB, WS_WD = 89 * MiB, WS_WR = 121 * MiB;
constexpr size_t WS_H = 128 * MiB;
constexpr size_t WS_FQ = 192 * MiB, WS_FK = 224 * MiB, WS_FV = 256 * MiB, WS_FOG = 288 * MiB, WS_DQ = 320 * MiB, WS_DK = 352 * MiB, WS_DV = 384 * MiB;
constexpr size_t WS_MERGED = 416 * MiB, WS_O1 = 480 * MiB, WS_O4 = 128 * MiB;
constexpr size_t WS_ACT = 192 * MiB, WS_Y = 264 * MiB;
constexpr size_t WS_END = 512 * MiB;
static_assert(WS_Y + (size_t)PROWS * D * 2 <= WS_MERGED, "Y overlay");
static_assert(WS_ACT + (size_t)PROWS * DE * 2 <= WS_Y, "ACT overlay");
}

typedef unsigned short bf16_t;
__host__ __device__ __forceinline__ float bf2f(bf16_t v) { return __builtin_bit_cast(float, ((unsigned)v) << 16); }
__host__ __device__ __forceinline__ bf16_t f2bf(float f) { unsigned u = __builtin_bit_cast(unsigned, f); return (bf16_t)((u + 0x7fffu + ((u >> 16) & 1u)) >> 16); }

namespace gold {
using namespace cfg;

__device__ __forceinline__ float wsum(float v) {
#pragma unroll
    for (int o = 1; o < 64; o <<= 1) v += __shfl_xor(v, o);
    return v;
}

__global__ void __launch_bounds__(256) k_mod(const float* c, const float* w_ada, const float* b_ada, float* mod) {
    const int j = blockIdx.x * 256 + threadIdx.x;
    __shared__ float sc[8][1024];
    for (int i = threadIdx.x; i < 8 * 1024; i += 256) { const float v = c[i]; sc[i >> 10][i & 1023] = v / (1.f + __expf(-v)); }
    __syncthreads();
    float acc[8];
#pragma unroll
    for (int b = 0; b < 8; ++b) acc[b] = 0.f;
    for (int k = 0; k < 1024; ++k) { const float w = w_ada[(size_t)k * 6144 + j];
#pragma unroll
        for (int b = 0; b < 8; ++b) acc[b] += sc[b][k] * w; }
#pragma unroll
    for (int b = 0; b < 8; ++b) mod[b * 6144 + j] = acc[b] + b_ada[j];
}

__global__ void __launch_bounds__(256) k_hpass(const float* x, const float* mod, const float* w_in, const float* b_forget, const int* positions,
                                               bf16_t* H, float* logf, float* cs) {
    const int lane = threadIdx.x & 63, row = blockIdx.x * 4 + (threadIdx.x >> 6);
    const int b = row / S;
    const float* xr = x + (size_t)row * D;
    const float* sh = mod + b * 6144, *sc = mod + b * 6144 + 1024;
    float ff[8];
#pragma unroll
    for (int h = 0; h < 8; ++h) ff[h] = 0.f;
    for (int j = 0; j < 16; ++j) { const int k = j * 64 + lane; const float hv = xr[k] * (1.f + sc[k]) + sh[k];
        H[(size_t)row * D + k] = f2bf(hv);
#pragma unroll
        for (int h = 0; h < 8; ++h) ff[h] += hv * w_in[(size_t)k * PROJ_LD + 2048 + h]; }
#pragma unroll
    for (int h = 0; h < 8; ++h) ff[h] = wsum(ff[h]);
    if (lane < 8) { float v = 0.f;
#pragma unroll
        for (int h = 0; h < 8; ++h) if (lane == h) v = ff[h];
        v += b_forget[lane];
        const float ls = fminf(v, 0.f) - log1pf(__expf(-fabsf(v)));
        logf[(size_t)row * 8 + lane] = ls; }
    if (lane >= 8 && lane < 16) { const int i = lane - 8; const float pos = (float)positions[row];
        const float invf = exp2f(-(float)i * 0.125f * 18.931568569324174f);
        const float ang = pos * invf;
        const double a = (double)ang; const double n = rint(a * 0.15915494309189535); const float r = (float)(a - n * 6.283185307179586);
        cs[(size_t)row * 16 + i] = __cosf(r); cs[(size_t)row * 16 + 8 + i] = __sinf(r); }
}

__global__ void __launch_bounds__(1024) k_cum(const float* logf, float* cb) {
    const int bh = blockIdx.x, b = bh >> 3, h = bh & 7, t = threadIdx.x;
    __shared__ double part[1024];
    double v[4]; double s = 0.0;
#pragma unroll
    for (int i = 0; i < 4; ++i) { s += (double)logf[((size_t)b * S + t * 4 + i) * 8 + h]; v[i] = s; }
    part[t] = s; __syncthreads();
    for (int o = 1; o < 1024; o <<= 1) { double add = (t >= o) ? part[t - o] : 0.0; __syncthreads(); part[t] += add; __syncthreads(); }
    const double base = (t > 0) ? part[t - 1] : 0.0;
#pragma unroll
    for (int i = 0; i < 4; ++i) cb[(size_t)bh * S + t * 4 + i] = (float)(-(base + v[i]) * 1.4426950408889634);
}

struct GemmArgs {
    const bf16_t* A; long long lda; const int* rowidx;
    const float* B; const float* B2; long long ldb; size_t bstride; const int* blk_e_poff;
    long long K;
};
template <class Epi, bool DUAL>
__global__ void __launch_bounds__(256) k_gemm(GemmArgs g, Epi epi) {
    __shared__ float As[16][68];
    __shared__ float Bs[16][64];
    __shared__ float Bs2[DUAL ? 16 : 1][64];
    __shared__ float Cs[64][65];
    __shared__ float Cs2[DUAL ? 64 : 1][65];
    const int tid = threadIdx.x, tx = tid & 15, ty = tid >> 4;
    const int row0 = blockIdx.y * 64, col0 = blockIdx.x * 64;
    const float* Bp = g.B; const float* Bp2 = g.B2;
    if (g.blk_e_poff) {
        if (row0 >= g.blk_e_poff[32]) return;
        int e = 0; for (int i = 1; i < 32; ++i) if (g.blk_e_poff[i] <= row0) e = i;
        Bp += (size_t)e * g.bstride; if (DUAL) Bp2 += (size_t)e * g.bstride;
    }
    const int ar = tid >> 2, ak = (tid & 3) * 4;
    int arow = row0 + ar; if (g.rowidx) { arow = g.rowidx[arow]; if (arow < 0) arow = 0; }
    const bf16_t* Ap = g.A + (size_t)arow * g.lda + ak;
    const int bk = tid >> 4, bc = (tid & 15) * 4;
    const int pcol = epi.bcol(col0 + bc);
    float acc[4][4], acc2[4][4];
#pragma unroll
    for (int i = 0; i < 4; ++i)
#pragma unroll
        for (int j = 0; j < 4; ++j) { acc[i][j] = 0.f; acc2[i][j] = 0.f; }
    for (int k0 = 0; k0 < (int)g.K; k0 += 16) {
        const uint2 av = *(const uint2*)(Ap + k0);
        As[ak + 0][ar] = bf2f((bf16_t)(av.x & 0xffff)); As[ak + 1][ar] = bf2f((bf16_t)(av.x >> 16));
        As[ak + 2][ar] = bf2f((bf16_t)(av.y & 0xffff)); As[ak + 3][ar] = bf2f((bf16_t)(av.y >> 16));
        *(float4*)&Bs[bk][bc] = *(const float4*)(Bp + (size_t)(k0 + bk) * g.ldb + pcol);
        if (DUAL) *(float4*)&Bs2[bk][bc] = *(const float4*)(Bp2 + (size_t)(k0 + bk) * g.ldb + pcol);
        __syncthreads();
#pragma unroll
        for (int k = 0; k < 16; ++k) {
            const float4 a = *(const float4*)&As[k][ty * 4]; const float4 bb = *(const float4*)&Bs[k][tx * 4];
            const float aa[4] = {a.x, a.y, a.z, a.w}, bv[4] = {bb.x, bb.y, bb.z, bb.w};
#pragma unroll
            for (int i = 0; i < 4; ++i)
#pragma unroll
                for (int j = 0; j < 4; ++j) acc[i][j] += aa[i] * bv[j];
            if (DUAL) { const float4 b2 = *(const float4*)&Bs2[k][tx * 4]; const float bw[4] = {b2.x, b2.y, b2.z, b2.w};
#pragma unroll
                for (int i = 0; i < 4; ++i)
#pragma unroll
                    for (int j = 0; j < 4; ++j) acc2[i][j] += aa[i] * bw[j]; }
        }
        __syncthreads();
    }
#pragma unroll
    for (int i = 0; i < 4; ++i)
#pragma unroll
        for (int j = 0; j < 4; ++j) { Cs[ty * 4 + i][tx * 4 + j] = acc[i][j]; if (DUAL) Cs2[ty * 4 + i][tx * 4 + j] = acc2[i][j]; }
    __syncthreads();
    for (int e = tid; e < 64 * 64; e += 256) { const int r = e >> 6, c = e & 63; epi(Cs, Cs2, r, c, row0, col0); }
}

struct EpiProj {
    bf16_t* base;
    const float* cs;
    __device__ int bcol(int c) const { return c < 2048 ? c : c + 8; }
    __device__ void operator()(const float (*Cs)[65], const float (*)[65], int r, int c, int row0, int col0) const {
        const int t = col0 >> 9, cc = (col0 & 511) + c, row = row0 + r;
        float v = Cs[r][c];
        if (t == 4 || t == 5) { if (c < 16) { const int i = c & 7; const float co = cs[(size_t)row * 16 + i], si = cs[(size_t)row * 16 + 8 + i];
                const float x1 = Cs[r][i], x2 = Cs[r][8 + i]; v = (c < 8) ? x1 * co - x2 * si : x2 * co + x1 * si; } }
        if (t == 0 || t == 4) v *= C2;
        if (t == 3) v = 1.f / (1.f + __expf(-v));
        bf16_t* o = (bf16_t*)((char*)base + (size_t)t * 32 * MiB);
        o[(size_t)row * GW + cc] = f2bf(v);
    }
};
struct EpiF32 {
    float* out; long long ld;
    __device__ int bcol(int c) const { return c; }
    __device__ void operator()(const float (*Cs)[65], const float (*)[65], int r, int c, int row0, int col0) const { out[(size_t)(row0 + r) * ld + col0 + c] = Cs[r][c]; }
};
struct EpiSwiglu {
    bf16_t* out;
    __device__ int bcol(int c) const { return c; }
    __device__ void operator()(const float (*Cs)[65], const float (*Cs2)[65], int r, int c, int row0, int col0) const {
        const float g = Cs[r][c], u = Cs2[r][c]; out[(size_t)(row0 + r) * DE + col0 + c] = f2bf(g / (1.f + __expf(-g)) * u); }
};
struct EpiBf16 {
    bf16_t* out; long long ld;
    __device__ int bcol(int c) const { return c; }
    __device__ void operator()(const float (*Cs)[65], const float (*)[65], int r, int c, int row0, int col0) const { out[(size_t)(row0 + r) * ld + col0 + c] = f2bf(Cs[r][c]); }
};

__global__ void __launch_bounds__(256) k_fox(const bf16_t* FQ, const bf16_t* FK, const bf16_t* FV, const bf16_t* FOG, const float* cb, bf16_t* merged) {
    const int qb = blockIdx.x, bh = blockIdx.y, b = bh >> 3, h = bh & 7, tid = threadIdx.x;
    const int t = qb * 256 + tid; const size_t rowb = (size_t)b * S;
    __shared__ float Ks[64][64]; __shared__ float Vs[64][64]; __shared__ float Bsm[64];
    float q[64], o[64];
    { const bf16_t* qp = FQ + (rowb + t) * GW + h * 64;
#pragma unroll
      for (int d = 0; d < 64; ++d) { q[d] = bf2f(qp[d]); o[d] = 0.f; } }
    float m = -INFINITY, l = 0.f;
    const int nt = (qb * 256 + 256) / 64;
    for (int kt = 0; kt < nt; ++kt) {
        __syncthreads();
        for (int e = tid; e < 64 * 64; e += 256) { const int r = e >> 6, d = e & 63; const size_t gi = (rowb + kt * 64 + r) * GW + h * 64 + d; Ks[r][d] = bf2f(FK[gi]); Vs[r][d] = bf2f(FV[gi]); }
        if (tid < 64) Bsm[tid] = cb[(size_t)bh * S + kt * 64 + tid];
        __syncthreads();
        for (int r = 0; r < 64; ++r) { const int s = kt * 64 + r; if (s > t) break;
            float sc = 0.f;
#pragma unroll
            for (int d = 0; d < 64; ++d) sc += q[d] * Ks[r][d];
            sc += Bsm[r];
            if (sc > m) { const float f = exp2f(m - sc); l *= f;
#pragma unroll
                for (int d = 0; d < 64; ++d) o[d] *= f;
                m = sc; }
            const float p = exp2f(sc - m); l += p;
#pragma unroll
            for (int d = 0; d < 64; ++d) o[d] += p * Vs[r][d]; }
    }
    const float il = 1.f / l;
    const bf16_t* gp = FOG + (rowb + t) * GW + h * 64; bf16_t* op = merged + (rowb + t) * D + h * 64;
#pragma unroll
    for (int d = 0; d < 64; ++d) op[d] = f2bf(o[d] * il * bf2f(gp[d]));
}

__global__ void __launch_bounds__(256) k_dil(const bf16_t* DQ, const bf16_t* DK, const bf16_t* DV, bf16_t* merged) {
    const int bh = blockIdx.y, b = bh >> 3, h = bh & 7; const int t = blockIdx.x * 256 + threadIdx.x; const size_t rowb = (size_t)b * S;
    float q[64], o[64];
    { const bf16_t* qp = DQ + (rowb + t) * GW + h * 64;
#pragma unroll
      for (int d = 0; d < 64; ++d) { q[d] = bf2f(qp[d]); o[d] = 0.f; } }
    float m = -INFINITY, l = 0.f;
    for (int p = 0; p < 3; ++p) { const int dil = (p == 0) ? 1 : (p == 1) ? 4 : 16;
        for (int j = 0; j <= 128; ++j) { const int s = t - j * dil; if (s < 0) break;
            const uint4* kp = (const uint4*)(DK + (rowb + s) * GW + h * 64); const uint4* vp = (const uint4*)(DV + (rowb + s) * GW + h * 64);
            float sc = 0.f;
#pragma unroll
            for (int c = 0; c < 8; ++c) { const uint4 kv = kp[c]; const unsigned w[4] = {kv.x, kv.y, kv.z, kv.w};
#pragma unroll
                for (int i = 0; i < 4; ++i) { sc += q[c * 8 + 2 * i] * bf2f((bf16_t)(w[i] & 0xffff)); sc += q[c * 8 + 2 * i + 1] * bf2f((bf16_t)(w[i] >> 16)); } }
            if (sc > m) { const float f = exp2f(m - sc); l *= f;
#pragma unroll
                for (int d = 0; d < 64; ++d) o[d] *= f;
                m = sc; }
            const float pr = exp2f(sc - m); l += pr;
#pragma unroll
            for (int c = 0; c < 8; ++c) { const uint4 vv = vp[c]; const unsigned w[4] = {vv.x, vv.y, vv.z, vv.w};
#pragma unroll
                for (int i = 0; i < 4; ++i) { o[c * 8 + 2 * i] += pr * bf2f((bf16_t)(w[i] & 0xffff)); o[c * 8 + 2 * i + 1] += pr * bf2f((bf16_t)(w[i] >> 16)); } }
        } }
    const float il = 1.f / l; bf16_t* op = merged + (rowb + t) * D + 512 + h * 64;
#pragma unroll
    for (int d = 0; d < 64; ++d) op[d] = f2bf(o[d] * il);
}

__global__ void __launch_bounds__(256) k_ln1_router(const float* x, const float* y, const float* mod, const float* g1, const float* b1,
                                                    const float* w_rg, const float* b_rg, const float* w_re, const float* b_re,
                                                    float* X1, bf16_t* H2, int* tope, float* topw) {
    const int lane = threadIdx.x & 63, row = blockIdx.x * 4 + (threadIdx.x >> 6); const int b = row / S;
    const float* gate = mod + b * 6144 + 2048, *sh2 = mod + b * 6144 + 3072, *sc2 = mod + b * 6144 + 4096;
    float v[16]; float s = 0.f;
#pragma unroll
    for (int j = 0; j < 16; ++j) { const int k = j * 64 + lane; v[j] = ALPHA * x[(size_t)row * D + k] + gate[k] * y[(size_t)row * D + k]; s += v[j]; }
    const float mean = wsum(s) * (1.f / D); float q = 0.f;
#pragma unroll
    for (int j = 0; j < 16; ++j) { v[j] -= mean; q += v[j] * v[j]; }
    const float rstd = 1.f / sqrtf(wsum(q) * (1.f / D) + LN_EPS);
    float lg[36];
#pragma unroll
    for (int i = 0; i < 36; ++i) lg[i] = 0.f;
#pragma unroll
    for (int j = 0; j < 16; ++j) { const int k = j * 64 + lane; const float x1 = v[j] * rstd * g1[k] + b1[k]; X1[(size_t)row * D + k] = x1;
        const float h2 = x1 * (1.f + sc2[k]) + sh2[k]; H2[(size_t)row * D + k] = f2bf(h2);
#pragma unroll
        for (int i = 0; i < 4; ++i) lg[i] += h2 * w_rg[k * 4 + i];
#pragma unroll
        for (int i = 0; i < 32; ++i) lg[4 + i] += h2 * w_re[k * 32 + i]; }
#pragma unroll
    for (int i = 0; i < 36; ++i) lg[i] = wsum(lg[i]);
    if (lane == 0) {
        float gl[4]; int g = 0;
#pragma unroll
        for (int i = 0; i < 4; ++i) gl[i] = lg[i] + b_rg[i];
        float gbest = gl[0];
#pragma unroll
        for (int i = 1; i < 4; ++i) if (gl[i] > gbest) { gbest = gl[i]; g = i; }
        float den = 0.f;
#pragma unroll
        for (int i = 0; i < 4; ++i) den += __expf(gl[i] - gbest);
        const float pg = 1.f / den;
        float el[8];
#pragma unroll
        for (int i = 0; i < 8; ++i) { float vv = 0.f;
#pragma unroll
            for (int gg = 0; gg < 4; ++gg) if (gg == g) vv = lg[4 + gg * 8 + i] + b_re[gg * 8 + i];
            el[i] = vv; }
        int i1 = 0; float v1 = el[0];
#pragma unroll
        for (int i = 1; i < 8; ++i) if (el[i] > v1) { v1 = el[i]; i1 = i; }
        int i2 = -1; float v2 = -INFINITY;
#pragma unroll
        for (int i = 0; i < 8; ++i) if (i != i1 && el[i] > v2) { v2 = el[i]; i2 = i; }
        const float e2 = __expf(v2 - v1); const float w1 = pg / (1.f + e2), w2 = pg * e2 / (1.f + e2);
        tope[row * 2] = g * 8 + i1; tope[row * 2 + 1] = g * 8 + i2; topw[row * 2] = w1; topw[row * 2 + 1] = w2;
    }
}

__global__ void __launch_bounds__(1024) k_sort(const int* tope, int* cnt_poff  , int* rowtok, int* slot) {
    __shared__ int cnt[32]; __shared__ int poff[33];
    const int tid = threadIdx.x, lane = tid & 63, w = tid >> 6;
    if (tid < 32) cnt[tid] = 0;
    __syncthreads();
    for (int e = w; e < 32; e += 16) { int c = 0;
        for (int a0 = 0; a0 < 2 * M; a0 += 64) { const bool mt = tope[a0 + lane] == e; c += __popcll(__ballot(mt)); }
        if (lane == 0) cnt[e] = c; }
    __syncthreads();
    if (tid == 0) { int p = 0; for (int e = 0; e < 32; ++e) { poff[e] = p; p += (cnt[e] + MOEB - 1) / MOEB * MOEB; } poff[32] = p; }
    __syncthreads();
    if (tid < 32) cnt_poff[tid] = cnt[tid];
    if (tid < 33) cnt_poff[32 + tid] = poff[tid];
    for (int i = tid; i < PROWS; i += 1024) rowtok[i] = -1;
    __syncthreads();
    for (int e = w; e < 32; e += 16) { int c = 0;
        for (int a0 = 0; a0 < 2 * M; a0 += 64) { const int a = a0 + lane; const bool mt = tope[a] == e; const unsigned long long bal = __ballot(mt);
            if (mt) { const int pos = poff[e] + c + __popcll(bal & ((1ull << lane) - 1ull)); rowtok[pos] = a >> 1; slot[a] = pos; }
            c += __popcll(bal); } }
}

__global__ void __launch_bounds__(256) k_final(float* X1out, const bf16_t* Y, const int* slot, const float* topw, const float* mod, const float* g2, const float* b2) {
    const int lane = threadIdx.x & 63, row = blockIdx.x * 4 + (threadIdx.x >> 6); const int b = row / S;
    const float* gate = mod + b * 6144 + 5120;
    const int s0 = slot[row * 2], s1 = slot[row * 2 + 1]; const float w0 = topw[row * 2], w1 = topw[row * 2 + 1];
    float v[16]; float s = 0.f;
#pragma unroll
    for (int j = 0; j < 16; ++j) { const int k = j * 64 + lane; const float y = w0 * bf2f(Y[(size_t)s0 * D + k]) + w1 * bf2f(Y[(size_t)s1 * D + k]);
        v[j] = ALPHA * X1out[(size_t)row * D + k] + gate[k] * y; s += v[j]; }
    const float mean = wsum(s) * (1.f / D); float q = 0.f;
#pragma unroll
    for (int j = 0; j < 16; ++j) { v[j] -= mean; q += v[j] * v[j]; }
    const float rstd = 1.f / sqrtf(wsum(q) * (1.f / D) + LN_EPS);
#pragma unroll
    for (int j = 0; j < 16; ++j) { const int k = j * 64 + lane; X1out[(size_t)row * D + k] = v[j] * rstd * g2[k] + b2[k]; }
}

inline void forward(void* const* d_in, float* out, unsigned char* ws, hipStream_t st) {
    const float* x = (const float*)d_in[0]; const float* c = (const float*)d_in[1]; const int* pos = (const int*)d_in[2];
    const float* w_ada = (const float*)d_in[3]; const float* b_ada = (const float*)d_in[4]; const float* w_in = (const float*)d_in[5];
    const float* b_forget = (const float*)d_in[6]; const float* w_out = (const float*)d_in[7]; const float* ln1_g = (const float*)d_in[8]; const float* ln1_b = (const float*)d_in[9];
    const float* w_rg = (const float*)d_in[10]; const float* b_rg = (const float*)d_in[11]; const float* w_re = (const float*)d_in[12]; const float* b_re = (const float*)d_in[13];
    const float* w_up = (const float*)d_in[14]; const float* w_gate = (const float*)d_in[15]; const float* w_down = (const float*)d_in[16];
    const float* ln2_g = (const float*)d_in[17]; const float* ln2_b = (const float*)d_in[18];
    float* mod = (float*)(ws + WS_MOD); float* cs = (float*)(ws + WS_CS); float* cb = (float*)(ws + WS_CB); float* logf = (float*)(ws + WS_LOGF);
    bf16_t* H = (bf16_t*)(ws + WS_H); bf16_t* FQ = (bf16_t*)(ws + WS_FQ); bf16_t* FK = (bf16_t*)(ws + WS_FK); bf16_t* FV = (bf16_t*)(ws + WS_FV); bf16_t* FOG = (bf16_t*)(ws + WS_FOG);
    bf16_t* DQ = (bf16_t*)(ws + WS_DQ); bf16_t* DK = (bf16_t*)(ws + WS_DK); bf16_t* DV = (bf16_t*)(ws + WS_DV); bf16_t* MG = (bf16_t*)(ws + WS_MERGED);
    int* tope = (int*)(ws + WS_TOPE); float* topw = (float*)(ws + WS_TOPW); int* slot = (int*)(ws + WS_SLOT); int* rowtok = (int*)(ws + WS_ROWTOK); int* cntp = (int*)(ws + WS_CNT);
    bf16_t* ACT = (bf16_t*)(ws + WS_ACT); bf16_t* Y = (bf16_t*)(ws + WS_Y);
    float* y1 = (float*)(ws + WS_FQ);
    k_mod<<<6144 / 256, 256, 0, st>>>(c, w_ada, b_ada, mod);
    k_hpass<<<M / 4, 256, 0, st>>>(x, mod, w_in, b_forget, pos, H, logf, cs);
    k_cum<<<64, 1024, 0, st>>>(logf, cb);
    { GemmArgs g{H, D, nullptr, w_in, nullptr, PROJ_LD, 0, nullptr, D}; EpiProj e{FQ, cs}; k_gemm<EpiProj, false><<<dim3(NPROJ / 64, M / 64), 256, 0, st>>>(g, e); }
    k_fox<<<dim3(S / 256, 64), 256, 0, st>>>(FQ, FK, FV, FOG, cb, MG);
    k_dil<<<dim3(S / 256, 64), 256, 0, st>>>(DQ, DK, DV, MG);
    { GemmArgs g{MG, D, nullptr, w_out, nullptr, D, 0, nullptr, D}; EpiF32 e{y1, D}; k_gemm<EpiF32, false><<<dim3(D / 64, M / 64), 256, 0, st>>>(g, e); }
    k_ln1_router<<<M / 4, 256, 0, st>>>(x, y1, mod, ln1_g, ln1_b, w_rg, b_rg, w_re, b_re, out, H, tope, topw);
    k_sort<<<1, 1024, 0, st>>>(tope, cntp, rowtok, slot);
    { GemmArgs g{H, D, rowtok, w_gate, w_up, DE, (size_t)D * DE, cntp + 32, D}; EpiSwiglu e{ACT}; k_gemm<EpiSwiglu, true><<<dim3(DE / 64, PROWS / 64), 256, 0, st>>>(g, e); }
    { GemmArgs g{ACT, DE, nullptr, w_down, nullptr, D, (size_t)DE * D, cntp + 32, DE}; EpiBf16 e{Y, D}; k_gemm<EpiBf16, false><<<dim3(D / 64, PROWS / 64), 256, 0, st>>>(g, e); }
    k_final<<<M / 4, 256, 0, st>>>(out, Y, slot, topw, mod, ln2_g, ln2_b);
}
}
extern "C" void kernel_launch(void* const* d_in, const int* in_sizes, int n_in, void* d_out, int out_size, void* d_ws, size_t ws_size, hipStream_t stream) {
    if (n_in != 19 || out_size != cfg::M * cfg::D || ws_size < cfg::WS_END) return;
    gold::forward(d_in, (float*)d_out, (unsigned char*)d_ws, stream);
}
```

```cpp
#include <hip/hip_runtime.h>
#include <cstdio>
#include <hip/hip_runtime.h>
#include <stdint.h>

namespace cfg {
constexpr int B = 8, S = 4096, D = 1024, M = B * S, NH = 8, HD = 64, GW = 512;
constexpr int PROJ_LD = 3592, NPROJ = 3584;
constexpr int NE = 32, EPG = 8, NG = 4, DE = 512, MOEB = 256;
constexpr int PROWS = 2 * M + NE * MOEB;
constexpr float LN_EPS = 1e-5f;
constexpr float ALPHA = 1.189207115002721f;
constexpr float LOG2E = 1.4426950408889634f;
constexpr float C2 = 0.125f * 1.4426950408889634f;
constexpr size_t MiB = 1u << 20;
constexpr size_t WS_CTL = 0, WS_MOD = 1 * MiB, WS_CNT = 2 * MiB, WS_CS = 3 * MiB, WS_CB = 5 * MiB, WS_LOGF = 6 * MiB;
constexpr size_t WS_TOPE = 7 * MiB, WS_TOPW = 7 * MiB + 256 * 1024, WS_SLOT = 7 * MiB + 512 * 1024;
constexpr size_t WS_ROWTOK = 8 * MiB, WS_ROWW = 8 * MiB + 512 * 1024;
constexpr size_t WS_LSE1 = 9 * MiB, WS_LSE4 = 10 * MiB;
constexpr size_t WS_WIN = 16 * MiB, WS_WOUT = 23 * MiB, WS_WGU = 25 * MiB, WS_WD = 89 * MiB, WS_WR = 121 * MiB;
constexpr size_t WS_H = 128 * MiB;
constexpr size_t WS_FQ = 192 * MiB, WS_FK = 224 * MiB, WS_FV = 256 * MiB, WS_FOG = 288 * MiB, WS_DQ = 320 * MiB, WS_DK = 352 * MiB, WS_DV = 384 * MiB;
constexpr size_t WS_MERGED = 416 * MiB, WS_O1 = 480 * MiB, WS_O4 = 128 * MiB;
constexpr size_t WS_ACT = 192 * MiB, WS_Y = 264 * MiB;
constexpr size_t WS_END = 512 * MiB;
static_assert(WS_Y + (size_t)PROWS * D * 2 <= WS_MERGED, "Y overlay");
static_assert(WS_ACT + (size_t)PROWS * DE * 2 <= WS_Y, "ACT overlay");
}

typedef unsigned short bf16_t;
__host__ __device__ __forceinline__ float bf2f(bf16_t v) { return __builtin_bit_cast(float, ((unsigned)v) << 16); }
__host__ __device__ __forceinline__ bf16_t f2bf(float f) { unsigned u = __builtin_bit_cast(unsigned, f); return (bf16_t)((u + 0x7fffu + ((u >> 16) & 1u)) >> 16); }

namespace gold {
using namespace cfg;

__device__ __forceinline__ float wsum(float v) {
#pragma unroll
    for (int o = 1; o < 64; o <<= 1) v += __shfl_xor(v, o);
    return v;
}

__global__ void __launch_bounds__(256) k_mod(const float* c, const float* w_ada, const float* b_ada, float* mod) {
    const int j = blockIdx.x * 256 + threadIdx.x;
    __shared__ float sc[8][1024];
    for (int i = threadIdx.x; i < 8 * 1024; i += 256) { const float v = c[i]; sc[i >> 10][i & 1023] = v / (1.f + __expf(-v)); }
    __syncthreads();
    float acc[8];
#pragma unroll
    for (int b = 0; b < 8; ++b) acc[b] = 0.f;
    for (int k = 0; k < 1024; ++k) { const float w = w_ada[(size_t)k * 6144 + j];
#pragma unroll
        for (int b = 0; b < 8; ++b) acc[b] += sc[b][k] * w; }
#pragma unroll
    for (int b = 0; b < 8; ++b) mod[b * 6144 + j] = acc[b] + b_ada[j];
}

__global__ void __launch_bounds__(256) k_hpass(const float* x, const float* mod, const float* w_in, const float* b_forget, const int* positions,
                                               bf16_t* H, float* logf, float* cs) {
    const int lane = threadIdx.x & 63, row = blockIdx.x * 4 + (threadIdx.x >> 6);
    const int b = row / S;
    const float* xr = x + (size_t)row * D;
    const float* sh = mod + b * 6144, *sc = mod + b * 6144 + 1024;
    float ff[8];
#pragma unroll
    for (int h = 0; h < 8; ++h) ff[h] = 0.f;
    for (int j = 0; j < 16; ++j) { const int k = j * 64 + lane; const float hv = xr[k] * (1.f + sc[k]) + sh[k];
        H[(size_t)row * D + k] = f2bf(hv);
#pragma unroll
        for (int h = 0; h < 8; ++h) ff[h] += hv * w_in[(size_t)k * PROJ_LD + 2048 + h]; }
#pragma unroll
    for (int h = 0; h < 8; ++h) ff[h] = wsum(ff[h]);
    if (lane < 8) { float v = 0.f;
#pragma unroll
        for (int h = 0; h < 8; ++h) if (lane == h) v = ff[h];
        v += b_forget[lane];
        const float ls = fminf(v, 0.f) - log1pf(__expf(-fabsf(v)));
        logf[(size_t)row * 8 + lane] = ls; }
    if (lane >= 8 && lane < 16) { const int i = lane - 8; const float pos = (float)positions[row];
        const float invf = exp2f(-(float)i * 0.125f * 18.931568569324174f);
        const float ang = pos * invf;
        const double a = (double)ang; const double n = rint(a * 0.15915494309189535); const float r = (float)(a - n * 6.283185307179586);
        cs[(size_t)row * 16 + i] = __cosf(r); cs[(size_t)row * 16 + 8 + i] = __sinf(r); }
}

__global__ void __launch_bounds__(1024) k_cum(const float* logf, float* cb) {
    const int bh = blockIdx.x, b = bh >> 3, h = bh & 7, t = threadIdx.x;
    __shared__ double part[1024];
    double v[4]; double s = 0.0;
#pragma unroll
    for (int i = 0; i < 4; ++i) { s += (double)logf[((size_t)b * S + t * 4 + i) * 8 + h]; v[i] = s; }
    part[t] = s; __syncthreads();
    for (int o = 1; o < 1024; o <<= 1) { double add = (t >= o) ? part[t - o] : 0.0; __syncthreads(); part[t] += add; __syncthreads(); }
    const double base = (t > 0) ? part[t - 1] : 0.0;
#pragma unroll
    for (int i = 0; i < 4; ++i) cb[(size_t)bh * S + t * 4 + i] = (float)(-(base + v[i]) * 1.4426950408889634);
}

struct GemmArgs {
    const bf16_t* A; long long lda; const int* rowidx;
    const float* B; const float* B2; long long ldb; size_t bstride; const int* blk_e_poff;
    long long K;
};
template <class Epi, bool DUAL>
__global__ void __launch_bounds__(256) k_gemm(GemmArgs g, Epi epi) {
    __shared__ float As[16][68];
    __shared__ float Bs[16][64];
    __shared__ float Bs2[DUAL ? 16 : 1][64];
    __shared__ float Cs[64][65];
    __shared__ float Cs2[DUAL ? 64 : 1][65];
    const int tid = threadIdx.x, tx = tid & 15, ty = tid >> 4;
    const int row0 = blockIdx.y * 64, col0 = blockIdx.x * 64;
    const float* Bp = g.B; const float* Bp2 = g.B2;
    if (g.blk_e_poff) {
        if (row0 >= g.blk_e_poff[32]) return;
        int e = 0; for (int i = 1; i < 32; ++i) if (g.blk_e_poff[i] <= row0) e = i;
        Bp += (size_t)e * g.bstride; if (DUAL) Bp2 += (size_t)e * g.bstride;
    }
    const int ar = tid >> 2, ak = (tid & 3) * 4;
    int arow = row0 + ar; if (g.rowidx) { arow = g.rowidx[arow]; if (arow < 0) arow = 0; }
    const bf16_t* Ap = g.A + (size_t)arow * g.lda + ak;
    const int bk = tid >> 4, bc = (tid & 15) * 4;
    const int pcol = epi.bcol(col0 + bc);
    float acc[4][4], acc2[4][4];
#pragma unroll
    for (int i = 0; i < 4; ++i)
#pragma unroll
        for (int j = 0; j < 4; ++j) { acc[i][j] = 0.f; acc2[i][j] = 0.f; }
    for (int k0 = 0; k0 < (int)g.K; k0 += 16) {
        const uint2 av = *(const uint2*)(Ap + k0);
        As[ak + 0][ar] = bf2f((bf16_t)(av.x & 0xffff)); As[ak + 1][ar] = bf2f((bf16_t)(av.x >> 16));
        As[ak + 2][ar] = bf2f((bf16_t)(av.y & 0xffff)); As[ak + 3][ar] = bf2f((bf16_t)(av.y >> 16));
        *(float4*)&Bs[bk][bc] = *(const float4*)(Bp + (size_t)(k0 + bk) * g.ldb + pcol);
        if (DUAL) *(float4*)&Bs2[bk][bc] = *(const float4*)(Bp2 + (size_t)(k0 + bk) * g.ldb + pcol);
        __syncthreads();
#pragma unroll
        for (int k = 0; k < 16; ++k) {
            const float4 a = *(const float4*)&As[k][ty * 4]; const float4 bb = *(const float4*)&Bs[k][tx * 4];
            const float aa[4] = {a.x, a.y, a.z, a.w}, bv[4] = {bb.x, bb.y, bb.z, bb.w};
#pragma unroll
            for (int i = 0; i < 4; ++i)
#pragma unroll
                for (int j = 0; j < 4; ++j) acc[i][j] += aa[i] * bv[j];
            if (DUAL) { const float4 b2 = *(const float4*)&Bs2[k][tx * 4]; const float bw[4] = {b2.x, b2.y, b2.z, b2.w};
#pragma unroll
                for (int i = 0; i < 4; ++i)
#pragma unroll
                    for (int j = 0; j < 4; ++j) acc2[i][j] += aa[i] * bw[j]; }
        }
        __syncthreads();
    }
#pragma unroll
    for (int i = 0; i < 4; ++i)
#pragma unroll
        for (int j = 0; j < 4; ++j) { Cs[ty * 4 + i][tx * 4 + j] = acc[i][j]; if (DUAL) Cs2[ty * 4 + i][tx * 4 + j] = acc2[i][j]; }
    __syncthreads();
    for (int e = tid; e < 64 * 64; e += 256) { const int r = e >> 6, c = e & 63; epi(Cs, Cs2, r, c, row0, col0); }
}

struct EpiProj {
    bf16_t* base;
    const float* cs;
    __device__ int bcol(int c) const { return c < 2048 ? c : c + 8; }
    __device__ void operator()(const float (*Cs)[65], const float (*)[65], int r, int c, int row0, int col0) const {
        const int t = col0 >> 9, cc = (col0 & 511) + c, row = row0 + r;
        float v = Cs[r][c];
        if (t == 4 || t == 5) { if (c < 16) { const int i = c & 7; const float co = cs[(size_t)row * 16 + i], si = cs[(size_t)row * 16 + 8 + i];
                const float x1 = Cs[r][i], x2 = Cs[r][8 + i]; v = (c < 8) ? x1 * co - x2 * si : x2 * co + x1 * si; } }
        if (t == 0 || t == 4) v *= C2;
        if (t == 3) v = 1.f / (1.f + __expf(-v));
        bf16_t* o = (bf16_t*)((char*)base + (size_t)t * 32 * MiB);
        o[(size_t)row * GW + cc] = f2bf(v);
    }
};
struct EpiF32 {
    float* out; long long ld;
    __device__ int bcol(int c) const { return c; }
    __device__ void operator()(const float (*Cs)[65], const float (*)[65], int r, int c, int row0, int col0) const { out[(size_t)(row0 + r) * ld + col0 + c] = Cs[r][c]; }
};
struct EpiSwiglu {
    bf16_t* out;
    __device__ int bcol(int c) const { return c; }
    __device__ void operator()(const float (*Cs)[65], const float (*Cs2)[65], int r, int c, int row0, int col0) const {
        const float g = Cs[r][c], u = Cs2[r][c]; out[(size_t)(row0 + r) * DE + col0 + c] = f2bf(g / (1.f + __expf(-g)) * u); }
};
struct EpiBf16 {
    bf16_t* out; long long ld;
    __device__ int bcol(int c) const { return c; }
    __device__ void operator()(const float (*Cs)[65], const float (*)[65], int r, int c, int row0, int col0) const { out[(size_t)(row0 + r) * ld + col0 + c] = f2bf(Cs[r][c]); }
};

__global__ void __launch_bounds__(256) k_fox(const bf16_t* FQ, const bf16_t* FK, const bf16_t* FV, const bf16_t* FOG, const float* cb, bf16_t* merged) {
    const int qb = blockIdx.x, bh = blockIdx.y, b = bh >> 3, h = bh & 7, tid = threadIdx.x;
    const int t = qb * 256 + tid; const size_t rowb = (size_t)b * S;
    __shared__ float Ks[64][64]; __shared__ float Vs[64][64]; __shared__ float Bsm[64];
    float q[64], o[64];
    { const bf16_t* qp = FQ + (rowb + t) * GW + h * 64;
#pragma unroll
      for (int d = 0; d < 64; ++d) { q[d] = bf2f(qp[d]); o[d] = 0.f; } }
    float m = -INFINITY, l = 0.f;
    const int nt = (qb * 256 + 256) / 64;
    for (int kt = 0; kt < nt; ++kt) {
        __syncthreads();
        for (int e = tid; e < 64 * 64; e += 256) { const int r = e >> 6, d = e & 63; const size_t gi = (rowb + kt * 64 + r) * GW + h * 64 + d; Ks[r][d] = bf2f(FK[gi]); Vs[r][d] = bf2f(FV[gi]); }
        if (tid < 64) Bsm[tid] = cb[(size_t)bh * S + kt * 64 + tid];
        __syncthreads();
        for (int r = 0; r < 64; ++r) { const int s = kt * 64 + r; if (s > t) break;
            float sc = 0.f;
#pragma unroll
            for (int d = 0; d < 64; ++d) sc += q[d] * Ks[r][d];
            sc += Bsm[r];
            if (sc > m) { const float f = exp2f(m - sc); l *= f;
#pragma unroll
                for (int d = 0; d < 64; ++d) o[d] *= f;
                m = sc; }
            const float p = exp2f(sc - m); l += p;
#pragma unroll
            for (int d = 0; d < 64; ++d) o[d] += p * Vs[r][d]; }
    }
    const float il = 1.f / l;
    const bf16_t* gp = FOG + (rowb + t) * GW + h * 64; bf16_t* op = merged + (rowb + t) * D + h * 64;
#pragma unroll
    for (int d = 0; d < 64; ++d) op[d] = f2bf(o[d] * il * bf2f(gp[d]));
}

__global__ void __launch_bounds__(256) k_dil(const bf16_t* DQ, const bf16_t* DK, const bf16_t* DV, bf16_t* merged) {
    const int bh = blockIdx.y, b = bh >> 3, h = bh & 7; const int t = blockIdx.x * 256 + threadIdx.x; const size_t rowb = (size_t)b * S;
    float q[64], o[64];
    { const bf16_t* qp = DQ + (rowb + t) * GW + h * 64;
#pragma unroll
      for (int d = 0; d < 64; ++d) { q[d] = bf2f(qp[d]); o[d] = 0.f; } }
    float m = -INFINITY, l = 0.f;
    for (int p = 0; p < 3; ++p) { const int dil = (p == 0) ? 1 : (p == 1) ? 4 : 16;
        for (int j = 0; j <= 128; ++j) { const int s = t - j * dil; if (s < 0) break;
            const uint4* kp = (const uint4*)(DK + (rowb + s) * GW + h * 64); const uint4* vp = (const uint4*)(DV + (rowb + s) * GW + h * 64);
            float sc = 0.f;
#pragma unroll
            for (int c = 0; c < 8; ++c) { const uint4 kv = kp[c]; const unsigned w[4] = {kv.x, kv.y, kv.z, kv.w};
#pragma unroll
                for (int i = 0; i < 4; ++i) { sc += q[c * 8 + 2 * i] * bf2f((bf16_t)(w[i] & 0xffff)); sc += q[c * 8 + 2 * i + 1] * bf2f((bf16_t)(w[i] >> 16)); } }
            if (sc > m) { const float f = exp2f(m - sc); l *= f;
#pragma unroll
                for (int d = 0; d < 64; ++d) o[d] *= f;
                m = sc; }
            const float pr = exp2f(sc - m); l += pr;
#pragma unroll
            for (int c = 0; c < 8; ++c) { const uint4 vv = vp[c]; const unsigned w[4] = {vv.x, vv.y, vv.z, vv.w};
#pragma unroll
                for (int i = 0; i < 4; ++i) { o[c * 8 + 2 * i] += pr * bf2f((bf16_t)(w[i] & 0xffff)); o[c * 8 + 2 * i + 1] += pr * bf2f((bf16_t)(w[i] >> 16)); } }
        } }
    const float il = 1.f / l; bf16_t* op = merged + (rowb + t) * D + 512 + h * 64;
#pragma unroll
    for (int d = 0; d < 64; ++d) op[d] = f2bf(o[d] * il);
}

__global__ void __launch_bounds__(256) k_ln1_router(const float* x, const float* y, const float* mod, const float* g1, const float* b1,
                                                    const float* w_rg, const float* b_rg, const float* w_re, const float* b_re,
                                                    float* X1, bf16_t* H2, int* tope, float* topw) {
    const int lane = threadIdx.x & 63, row = blockIdx.x * 4 + (threadIdx.x >> 6); const int b = row / S;
    const float* gate = mod + b * 6144 + 2048, *sh2 = mod + b * 6144 + 3072, *sc2 = mod + b * 6144 + 4096;
    float v[16]; float s = 0.f;
#pragma unroll
    for (int j = 0; j < 16; ++j) { const int k = j * 64 + lane; v[j] = ALPHA * x[(size_t)row * D + k] + gate[k] * y[(size_t)row * D + k]; s += v[j]; }
    const float mean = wsum(s) * (1.f / D); float q = 0.f;
#pragma unroll
    for (int j = 0; j < 16; ++j) { v[j] -= mean; q += v[j] * v[j]; }
    const float rstd = 1.f / sqrtf(wsum(q) * (1.f / D) + LN_EPS);
    float lg[36];
#pragma unroll
    for (int i = 0; i < 36; ++i) lg[i] = 0.f;
#pragma unroll
    for (int j = 0; j < 16; ++j) { const int k = j * 64 + lane; const float x1 = v[j] * rstd * g1[k] + b1[k]; X1[(size_t)row * D + k] = x1;
        const float h2 = x1 * (1.f + sc2[k]) + sh2[k]; H2[(size_t)row * D + k] = f2bf(h2);
#pragma unroll
        for (int i = 0; i < 4; ++i) lg[i] += h2 * w_rg[k * 4 + i];
#pragma unroll
        for (int i = 0; i < 32; ++i) lg[4 + i] += h2 * w_re[k * 32 + i]; }
#pragma unroll
    for (int i = 0; i < 36; ++i) lg[i] = wsum(lg[i]);
    if (lane == 0) {
        float gl[4]; int g = 0;
#pragma unroll
        for (int i = 0; i < 4; ++i) gl[i] = lg[i] + b_rg[i];
        float gbest = gl[0];
#pragma unroll
        for (int i = 1; i < 4; ++i) if (gl[i] > gbest) { gbest = gl[i]; g = i; }
        float den = 0.f;
#pragma unroll
        for (int i = 0; i < 4; ++i) den += __expf(gl[i] - gbest);
        const float pg = 1.f / den;
        float el[8];
#pragma unroll
        for (int i = 0; i < 8; ++i) { float vv = 0.f;
#pragma unroll
            for (int gg = 0; gg < 4; ++gg) if (gg == g) vv = lg[4 + gg * 8 + i] + b_re[gg * 8 + i];
            el[i] = vv; }
        int i1 = 0; float v1 = el[0];
#pragma unroll
        for (int i = 1; i < 8; ++i) if (el[i] > v1) { v1 = el[i]; i1 = i; }
        int i2 = -1; float v2 = -INFINITY;
#pragma unroll
        for (int i = 0; i < 8; ++i) if (i != i1 && el[i] > v2) { v2 = el[i]; i2 = i; }
        const float e2 = __expf(v2 - v1); const float w1 = pg / (1.f + e2), w2 = pg * e2 / (1.f + e2);
        tope[row * 2] = g * 8 + i1; tope[row * 2 + 1] = g * 8 + i2; topw[row * 2] = w1; topw[row * 2 + 1] = w2;
    }
}

__global__ void __launch_bounds__(1024) k_sort(const int* tope, int* cnt_poff  , int* rowtok, int* slot) {
    __shared__ int cnt[32]; __shared__ int poff[33];
    const int tid = threadIdx.x, lane = tid & 63, w = tid >> 6;
    if (tid < 32) cnt[tid] = 0;
    __syncthreads();
    for (int e = w; e < 32; e += 16) { int c = 0;
        for (int a0 = 0; a0 < 2 * M; a0 += 64) { const bool mt = tope[a0 + lane] == e; c += __popcll(__ballot(mt)); }
        if (lane == 0) cnt[e] = c; }
    __syncthreads();
    if (tid == 0) { int p = 0; for (int e = 0; e < 32; ++e) { poff[e] = p; p += (cnt[e] + MOEB - 1) / MOEB * MOEB; } poff[32] = p; }
    __syncthreads();
    if (tid < 32) cnt_poff[tid] = cnt[tid];
    if (tid < 33) cnt_poff[32 + tid] = poff[tid];
    for (int i = tid; i < PROWS; i += 1024) rowtok[i] = -1;
    __syncthreads();
    for (int e = w; e < 32; e += 16) { int c = 0;
        for (int a0 = 0; a0 < 2 * M; a0 += 64) { const int a = a0 + lane; const bool mt = tope[a] == e; const unsigned long long bal = __ballot(mt);
            if (mt) { const int pos = poff[e] + c + __popcll(bal & ((1ull << lane) - 1ull)); rowtok[pos] = a >> 1; slot[a] = pos; }
            c += __popcll(bal); } }
}

__global__ void __launch_bounds__(256) k_final(float* X1out, const bf16_t* Y, const int* slot, const float* topw, const float* mod, const float* g2, const float* b2) {
    const int lane = threadIdx.x & 63, row = blockIdx.x * 4 + (threadIdx.x >> 6); const int b = row / S;
    const float* gate = mod + b * 6144 + 5120;
    const int s0 = slot[row * 2], s1 = slot[row * 2 + 1]; const float w0 = topw[row * 2], w1 = topw[row * 2 + 1];
    float v[16]; float s = 0.f;
#pragma unroll
    for (int j = 0; j < 16; ++j) { const int k = j * 64 + lane; const float y = w0 * bf2f(Y[(size_t)s0 * D + k]) + w1 * bf2f(Y[(size_t)s1 * D + k]);
        v[j] = ALPHA * X1out[(size_t)row * D + k] + gate[k] * y; s += v[j]; }
    const float mean = wsum(s) * (1.f / D); float q = 0.f;
#pragma unroll
    for (int j = 0; j < 16; ++j) { v[j] -= mean; q += v[j] * v[j]; }
    const float rstd = 1.f / sqrtf(wsum(q) * (1.f / D) + LN_EPS);
#pragma unroll
    for (int j = 0; j < 16; ++j) { const int k = j * 64 + lane; X1out[(size_t)row * D + k] = v[j] * rstd * g2[k] + b2[k]; }
}

inline void forward(void* const* d_in, float* out, unsigned char* ws, hipStream_t st) {
    const float* x = (const float*)d_in[0]; const float* c = (const float*)d_in[1]; const int* pos = (const int*)d_in[2];
    const float* w_ada = (const float*)d_in[3]; const float* b_ada = (const float*)d_in[4]; const float* w_in = (const float*)d_in[5];
    const float* b_forget = (const float*)d_in[6]; const float* w_out = (const float*)d_in[7]; const float* ln1_g = (const float*)d_in[8]; const float* ln1_b = (const float*)d_in[9];
    const float* w_rg = (const float*)d_in[10]; const float* b_rg = (const float*)d_in[11]; const float* w_re = (const float*)d_in[12]; const float* b_re = (const float*)d_in[13];
    const float* w_up = (const float*)d_in[14]; const float* w_gate = (const float*)d_in[15]; const float* w_down = (const float*)d_in[16];
    const float* ln2_g = (const float*)d_in[17]; const float* ln2_b = (const float*)d_in[18];
    float* mod = (float*)(ws + WS_MOD); float* cs = (float*)(ws + WS_CS); float* cb = (float*)(ws + WS_CB); float* logf = (float*)(ws + WS_LOGF);
    bf16_t* H = (bf16_t*)(ws + WS_H); bf16_t* FQ = (bf16_t*)(ws + WS_FQ); bf16_t* FK = (bf16_t*)(ws + WS_FK); bf16_t* FV = (bf16_t*)(ws + WS_FV); bf16_t* FOG = (bf16_t*)(ws + WS_FOG);
    bf16_t* DQ = (bf16_t*)(ws + WS_DQ); bf16_t* DK = (bf16_t*)(ws + WS_DK); bf16_t* DV = (bf16_t*)(ws + WS_DV); bf16_t* MG = (bf16_t*)(ws + WS_MERGED);
    int* tope = (int*)(ws + WS_TOPE); float* topw = (float*)(ws + WS_TOPW); int* slot = (int*)(ws + WS_SLOT); int* rowtok = (int*)(ws + WS_ROWTOK); int* cntp = (int*)(ws + WS_CNT);
    bf16_t* ACT = (bf16_t*)(ws + WS_ACT); bf16_t* Y = (bf16_t*)(ws + WS_Y);
    float* y1 = (float*)(ws + WS_FQ);
    k_mod<<<6144 / 256, 256, 0, st>>>(c, w_ada, b_ada, mod);
    k_hpass<<<M / 4, 256, 0, st>>>(x, mod, w_in, b_forget, pos, H, logf, cs);
    k_cum<<<64, 1024, 0, st>>>(logf, cb);
    { GemmArgs g{H, D, nullptr, w_in, nullptr, PROJ_LD, 0, nullptr, D}; EpiProj e{FQ, cs}; k_gemm<EpiProj, false><<<dim3(NPROJ / 64, M / 64), 256, 0, st>>>(g, e); }
    k_fox<<<dim3(S / 256, 64), 256, 0, st>>>(FQ, FK, FV, FOG, cb, MG);
    k_dil<<<dim3(S / 256, 64), 256, 0, st>>>(DQ, DK, DV, MG);
    { GemmArgs g{MG, D, nullptr, w_out, nullptr, D, 0, nullptr, D}; EpiF32 e{y1, D}; k_gemm<EpiF32, false><<<dim3(D / 64, M / 64), 256, 0, st>>>(g, e); }
    k_ln1_router<<<M / 4, 256, 0, st>>>(x, y1, mod, ln1_g, ln1_b, w_rg, b_rg, w_re, b_re, out, H, tope, topw);
    k_sort<<<1, 1024, 0, st>>>(tope, cntp, rowtok, slot);
    { GemmArgs g{H, D, rowtok, w_gate, w_up, DE, (size_t)D * DE, cntp + 32, D}; EpiSwiglu e{ACT}; k_gemm<EpiSwiglu, true><<<dim3(DE / 64, PROWS / 64), 256, 0, st>>>(g, e); }
    { GemmArgs g{ACT, DE, nullptr, w_down, nullptr, D, (size_t)DE * D, cntp + 32, DE}; EpiBf16 e{Y, D}; k_gemm<EpiBf16, false><<<dim3(D / 64, PROWS / 64), 256, 0, st>>>(g, e); }
    k_final<<<M / 4, 256, 0, st>>>(out, Y, slot, topw, mod, ln2_g, ln2_b);
}
}
namespace pg8 {
#define PG8_LAS __attribute__((address_space(3)))
typedef short bf16x8 __attribute__((ext_vector_type(8)));
typedef float f32x4 __attribute__((ext_vector_type(4)));
typedef float f32x2 __attribute__((ext_vector_type(2)));
typedef unsigned u32x4 __attribute__((ext_vector_type(4)));
typedef unsigned u32x2 __attribute__((ext_vector_type(2)));
constexpr int BM = 256, BK = 64, HALF = 128, HTB = HALF * BK * 2  , STAGE_BYTES = 8 * HTB, NXCD = 8, WGM = 8;

__host__ __device__ __forceinline__ int lds_byte(int r, int c) { const int st = (r >> 4) * 2 + (c >> 5), rr = r & 15, cc = c & 31, ob = rr * 64 + cc * 2; return st * 1024 + (ob ^ (((ob >> 9) & 1) << 5)); }
__host__ __device__ __forceinline__ void stage_rc(int b, int& R, int& C) { const int st = b / 1024, sb = b % 1024, swz = sb ^ (((sb >> 9) & 1) << 5); R = (st >> 1) * 16 + swz / 64; C = (st & 1) * 32 + (swz % 64) / 2; }
__host__ __device__ __forceinline__ int perm32(int rho) { const int n = rho >> 4, i = rho & 15; return 8 * (i >> 2) + 4 * n + (i & 3); }

struct Unit { int pm, pn, e; };

__device__ __forceinline__ unsigned cvt_pk_bf16(float lo, float hi) { unsigned r; asm volatile("v_cvt_pk_bf16_f32 %0, %1, %2" : "=v"(r) : "v"(lo), "v"(hi)); return r; }

struct StaticOrder {
    int nM, nN, nwg, G, c;
    __device__ void init(int M, int N, int G_, int c_) { nM = M / BM; nN = N / BM; nwg = nM * nN; G = G_; c = c_; }
    __device__ bool next(int i, Unit& u) const {
        const long L = (long)i * G + c; if (L >= nwg) return false;
        int wgid = (int)L; { const int q = nwg / NXCD, r = nwg % NXCD, xcd = wgid % NXCD, off = wgid / NXCD; wgid = (xcd < r ? xcd * (q + 1) : r * (q + 1) + (xcd - r) * q) + off; }
        const int nig = WGM * nN, gid = wgid / nig, fm = gid * WGM, gsz = (nM - fm) < WGM ? (nM - fm) : WGM;
        u.pm = fm + ((wgid % nig) % gsz); u.pn = (wgid % nig) / gsz; u.e = 0; return true;
    }
};
struct DenseSched {
    const bf16_t* A; const bf16_t* Bt; int K; StaticOrder so;
    __device__ __forceinline__ bool next(int i, Unit& u) const { return so.next(i, u); }
    __device__ __forceinline__ const char* a_base(const Unit& u) const { return (const char*)A + (size_t)u.pm * BM * K * 2; }
    __device__ __forceinline__ const char* b_base(const Unit& u) const { return (const char*)Bt + (size_t)u.pn * BM * K * 2; }
    __device__ __forceinline__ void a_off(int, const Unit&, const int (&R)[2], const int (&C)[2], unsigned (&vo)[2][2]) const {
#pragma unroll
        for (int h = 0; h < 2; ++h)
#pragma unroll
            for (int i = 0; i < 2; ++i) vo[h][i] = (unsigned)((h * HALF + R[i]) * K + C[i]) * 2u; }
    __device__ __forceinline__ void a_ready(const Unit&) const {}
    __device__ __forceinline__ void done(const Unit&) const {}
};
template <bool GATHER> struct MoeSched {
    const bf16_t* A; const bf16_t* Bt; int K; size_t estride; int NT; int G, c;
    const PG8_LAS int* poff; const PG8_LAS int* tl;
    __device__ __forceinline__ bool next(int i, Unit& u) const {
        const int L = i * G + c; const int rb = L / NT; if (rb * BM >= poff[32]) return false;
        int e = 0;
#pragma unroll 1
        for (int j = 1; j < 32; ++j) if (poff[j] <= rb * BM) e = j;
        u.pm = rb; u.pn = L % NT; u.e = e; return true; }
    __device__ __forceinline__ const char* a_base(const Unit& u) const { return GATHER ? (const char*)A : (const char*)A + (size_t)u.pm * BM * K * 2; }
    __device__ __forceinline__ const char* b_base(const Unit& u) const { return (const char*)Bt + (size_t)u.e * estride + (size_t)u.pn * BM * K * 2; }
    __device__ __forceinline__ void a_off(int ui, const Unit&, const int (&R)[2], const int (&C)[2], unsigned (&vo)[2][2]) const {
#pragma unroll
        for (int h = 0; h < 2; ++h)
#pragma unroll
            for (int i = 0; i < 2; ++i) { const int row = GATHER ? tl[ui * BM + h * HALF + R[i]] : h * HALF + R[i]; vo[h][i] = (unsigned)(row * K + C[i]) * 2u; } }
    __device__ __forceinline__ void a_ready(const Unit&) const {}
    __device__ __forceinline__ void done(const Unit&) const {}
};

template <class Epi, class Sched, bool ALIGN_EPI>
__device__ __forceinline__ void gemm_phase(PG8_LAS unsigned char* lds, const int K, const Sched& S, const Epi& E) {
    const int tid = threadIdx.x, wid = __builtin_amdgcn_readfirstlane(tid >> 6), lane = tid & 63, wr = wid >> 2, wc = wid & 3, fr = lane & 15, fq = lane >> 4;
    const int nt = K / BK;
    int Rr[2], Cc[2]; unsigned voffB[2];
#pragma unroll
    for (int i = 0; i < 2; ++i) { stage_rc(tid * 16 + i * 8192, Rr[i], Cc[i]); const int Rb = Epi::PERM ? ((Rr[i] & ~31) + perm32(Rr[i] & 31)) : Rr[i];
        voffB[i] = (unsigned)(Rb * K + Cc[i]) * 2u; }
    const size_t kstep = (size_t)(BK * 2);
    const size_t hstep = (size_t)HALF * K * 2;
    const unsigned ldsw = (unsigned)wid * 1024u;
    const int aoff = lds_byte(wr * 64 + fr, fq * 8), boff = lds_byte(wc * 32 + fr, fq * 8);
#define PG8_SA(b, h) (((b) * 2 + (h)) * HTB)
#define PG8_SB(b, h) ((4 + (b) * 2 + (h)) * HTB)
#define PG8_STAGE(bufoff, gbase, voff) do { _Pragma("unroll") for (int _i = 0; _i < 2; ++_i) \
        __builtin_amdgcn_global_load_lds((const unsigned*)((const char*)(gbase) + (voff)[_i]), (PG8_LAS unsigned*)(lds + (bufoff) + ldsw + _i * 8192), 16, 0, 0); } while (0)
#define PG8_LDA(dst, b, h) do { _Pragma("unroll") for (int m = 0; m < 4; ++m) _Pragma("unroll") for (int k = 0; k < 2; ++k) dst[m][k] = *(const PG8_LAS bf16x8*)(lds + PG8_SA(b, h) + aoff + m * 2048 + k * 1024); } while (0)
#define PG8_LDB(dst, b, h) do { _Pragma("unroll") for (int n = 0; n < 2; ++n) _Pragma("unroll") for (int k = 0; k < 2; ++k) dst[n][k] = *(const PG8_LAS bf16x8*)(lds + PG8_SB(b, h) + boff + n * 2048 + k * 1024); } while (0)
#define PG8_MMA(ai, bj, At, Bt) do { __builtin_amdgcn_s_setprio(1); _Pragma("unroll") for (int m = 0; m < 4; ++m) _Pragma("unroll") for (int n = 0; n < 2; ++n) _Pragma("unroll") for (int k = 0; k < 2; ++k) \
        acc[ai][bj][m][n] = __builtin_amdgcn_mfma_f32_16x16x32_bf16(Bt[n][k], At[m][k], acc[ai][bj][m][n], 0, 0, 0); __builtin_amdgcn_s_setprio(0); } while (0)
#define PG8_WAIT_V(n) asm volatile("s_waitcnt vmcnt(" #n ")" ::: "memory")
#define PG8_WAIT_L(n) asm volatile("s_waitcnt lgkmcnt(" #n ")" ::: "memory")
#define PG8_BAR __builtin_amdgcn_s_barrier()
#define PG8_SCHED __builtin_amdgcn_sched_barrier(0)
    Unit cur, nxt; int ui = 0;
    if (!S.next(0, cur)) return;
    f32x4 acc[2][2][4][2];
#pragma unroll
    for (int a = 0; a < 2; ++a)
#pragma unroll
        for (int b = 0; b < 2; ++b)
#pragma unroll
            for (int m = 0; m < 4; ++m)
#pragma unroll
                for (int n = 0; n < 2; ++n) acc[a][b][m][n] = (f32x4){0.f, 0.f, 0.f, 0.f};
    bf16x8 At[4][2], B0[2][2], B1[2][2];
    unsigned cvo[2][2], nvo[2][2];
    S.a_off(0, cur, Rr, Cc, cvo);
    const char* cA = S.a_base(cur); const char* cB = S.b_base(cur);
    S.a_ready(cur);
    PG8_STAGE(PG8_SB(0, 0), cB, voffB); PG8_STAGE(PG8_SB(0, 1), cB + hstep, voffB); PG8_STAGE(PG8_SA(0, 0), cA, cvo[0]); PG8_STAGE(PG8_SA(0, 1), cA, cvo[1]);
    if (wr == 1) PG8_BAR;
    PG8_WAIT_V(2); PG8_BAR;
    PG8_STAGE(PG8_SB(1, 0), cB + kstep, voffB); PG8_STAGE(PG8_SA(1, 0), cA + kstep, cvo[0]); PG8_STAGE(PG8_SB(1, 1), cB + hstep + kstep, voffB);
    PG8_WAIT_V(6); PG8_BAR;
    for (;;) {
        const bool has_next = S.next(ui + 1, nxt);
        const char* nA = has_next ? S.a_base(nxt) : cA; const char* nB = has_next ? S.b_base(nxt) : cB;
        if (has_next) S.a_off(ui + 1, nxt, Rr, Cc, nvo);
        else {
#pragma unroll
            for (int h = 0; h < 2; ++h)
#pragma unroll
                for (int i = 0; i < 2; ++i) nvo[h][i] = cvo[h][i]; }
        for (int t = 0; t < nt; t += 2) {
            const bool last = (t == nt - 2);
            const char* a1 = cA + (size_t)(t + 1) * kstep;
            const char* a2 = last ? nA : cA + (size_t)(t + 2) * kstep; const char* b2 = last ? nB : cB + (size_t)(t + 2) * kstep;
            const char* a3 = a2 + kstep; const char* b3 = b2 + kstep;
            unsigned vo2[2][2];
#pragma unroll
            for (int h = 0; h < 2; ++h)
#pragma unroll
                for (int i = 0; i < 2; ++i) vo2[h][i] = last ? nvo[h][i] : cvo[h][i];
            if (last && has_next) S.a_ready(nxt);
            PG8_LDB(B0, 0, 0); PG8_LDB(B1, 0, 1); PG8_SCHED; PG8_LDA(At, 0, 0); PG8_STAGE(PG8_SA(1, 1), a1, cvo[1]);
            PG8_WAIT_V(8); PG8_WAIT_L(0); PG8_BAR; PG8_MMA(0, 0, At, B0); PG8_MMA(0, 1, At, B1); PG8_BAR; PG8_SCHED;
            PG8_LDA(At, 0, 1); PG8_STAGE(PG8_SB(0, 0), b2, voffB); PG8_STAGE(PG8_SB(0, 1), b2 + hstep, voffB); PG8_STAGE(PG8_SA(0, 0), a2, vo2[0]);
            PG8_WAIT_V(8); PG8_WAIT_L(0); PG8_BAR; PG8_MMA(1, 0, At, B0); PG8_MMA(1, 1, At, B1); PG8_BAR; PG8_SCHED;
            PG8_LDB(B0, 1, 0); PG8_LDB(B1, 1, 1); PG8_SCHED; PG8_LDA(At, 1, 0); PG8_STAGE(PG8_SA(0, 1), a2, vo2[1]);
            PG8_WAIT_V(8); PG8_WAIT_L(0); PG8_BAR; PG8_MMA(0, 0, At, B0); PG8_MMA(0, 1, At, B1); PG8_BAR; PG8_SCHED;
            PG8_LDA(At, 1, 1); PG8_STAGE(PG8_SB(1, 0), b3, voffB); PG8_STAGE(PG8_SB(1, 1), b3 + hstep, voffB); PG8_STAGE(PG8_SA(1, 0), a3, vo2[0]);
            PG8_WAIT_V(8); PG8_WAIT_L(0); PG8_BAR; PG8_MMA(1, 0, At, B0); PG8_MMA(1, 1, At, B1); PG8_BAR; PG8_SCHED;
        }
        if constexpr (ALIGN_EPI) { if (wr == 0) PG8_BAR; }
        E(acc, cur, wr, wc, fr, fq); S.done(cur);
        if (!has_next) break;
#pragma unroll
        for (int a = 0; a < 2; ++a)
#pragma unroll
            for (int b = 0; b < 2; ++b)
#pragma unroll
                for (int m = 0; m < 4; ++m)
#pragma unroll
                    for (int n = 0; n < 2; ++n) acc[a][b][m][n] = (f32x4){0.f, 0.f, 0.f, 0.f};
        cur = nxt; cA = nA; cB = nB; ++ui;
#pragma unroll
        for (int h = 0; h < 2; ++h)
#pragma unroll
            for (int i = 0; i < 2; ++i) cvo[h][i] = nvo[h][i];
        if constexpr (ALIGN_EPI) { if (wr == 1) PG8_BAR; }
    }
    PG8_WAIT_V(0);
    if constexpr (!ALIGN_EPI) { if (wr == 0) PG8_BAR; }
    PG8_BAR;
#undef PG8_SA
#undef PG8_SB
#undef PG8_STAGE
#undef PG8_LDA
#undef PG8_LDB
#undef PG8_MMA
#undef PG8_WAIT_V
#undef PG8_WAIT_L
#undef PG8_BAR
#undef PG8_SCHED
}
}

#define GAS __attribute__((address_space(1)))
#define LAS __attribute__((address_space(3)))
typedef unsigned v4u __attribute__((ext_vector_type(4)));
typedef unsigned v2u __attribute__((ext_vector_type(2)));
typedef float f32x4 __attribute__((ext_vector_type(4)));
typedef GAS unsigned gu32;
#define RLX_AGENT __ATOMIC_RELAXED, __HIP_MEMORY_SCOPE_AGENT
#define LDS_WAIT() asm volatile("s_waitcnt lgkmcnt(0)" ::: "memory")
#define VM_WAIT() asm volatile("s_waitcnt vmcnt(0)" ::: "memory")
__device__ __forceinline__ unsigned pk2(float lo, float hi) { return (unsigned)f2bf(lo) | ((unsigned)f2bf(hi) << 16); }

namespace mk {
using namespace cfg;
using pg8::Unit;
constexpr int NWAVES = 8;
constexpr int LCAP = 32768;
constexpr size_t WS_LIST = 9 * MiB;
constexpr size_t WS_SLOTPOS = 13 * MiB;
constexpr size_t WS_LSEA = 14 * MiB, WS_LSEB = 15 * MiB;
constexpr int CW_BAR = 4096;
constexpr int CW_CNT = 65536;
constexpr int RING_OFF = 0, RING_BYTES = 131072, TL_OFF = RING_BYTES, TL_BYTES = 8192, LDSCTL_OFF = TL_OFF + TL_BYTES, LDS_BYTES = 147456;
constexpr int LC_POFF = 0, LC_CNT = 64, LC_HIST = 128, LC_BASE = 160, LC_BAR = 256;

#define XB_TMO      128
#define XB_XCNT(j)  (256  + 64 * (j))
#define XB_XSUB(j)  (1280 + 64 * (j))
#define XB_XGEN(j)  (2304 + 64 * (j))
#define XB_TOP      3328
#define XB_TOPGEN   3392
#define XCD_BAR_WORDS 3456
#define XB_SPIN_CAP (1u << 18)
__device__ __forceinline__ unsigned xb_ld(unsigned* p)              { return __hip_atomic_load(p, __ATOMIC_RELAXED, __HIP_MEMORY_SCOPE_AGENT); }
__device__ __forceinline__ unsigned xb_add(unsigned* p, unsigned v) { return __hip_atomic_fetch_add(p, v, __ATOMIC_RELAXED, __HIP_MEMORY_SCOPE_AGENT); }
__device__ __forceinline__ unsigned xb_xcc_id() { return (unsigned)__builtin_amdgcn_s_getreg((3 << 11) | 20) & 0xFu; }
#define XB_SPIN(cond, bar) do { unsigned _sp = 0; while (cond) { __builtin_amdgcn_s_sleep(1); \
    if ((++_sp & 255u) == 0u) { if (xb_ld(&(bar)[XB_TMO])) break; if (_sp > XB_SPIN_CAP) { atomicAdd(&(bar)[XB_TMO], 1u); break; } } } } while (0)
struct XcdBarrier { unsigned* bar; unsigned x; volatile LAS unsigned* st; };
__device__ __forceinline__ XcdBarrier xcd_barrier_post(unsigned* bar, volatile LAS unsigned* st) {
    XcdBarrier b; b.bar = bar; b.x = xb_xcc_id(); b.st = st;
    if (threadIdx.x == 0) (void)xb_add(&bar[XB_XCNT(b.x)], 1u);
    return b;
}
__device__ __forceinline__ void xcd_barrier_complete(unsigned* bar, unsigned x, unsigned& nloc, unsigned& nx) {
    const unsigned G = gridDim.x * gridDim.y * gridDim.z;
    unsigned sum, cnt, mine, sp = 0u;
    for (;;) {
        sum = 0u; cnt = 0u; mine = 0u;
#pragma unroll
        for (unsigned j = 0; j < 16; ++j) { const unsigned c = xb_ld(&bar[XB_XCNT(j)]); sum += c; cnt += (c > 0u) ? 1u : 0u; mine = (j == x) ? c : mine; }
        if (sum == G) break;
        __builtin_amdgcn_s_sleep(1);
        if ((++sp & 255u) == 0u) { if (xb_ld(&bar[XB_TMO])) break; if (sp > XB_SPIN_CAP) { atomicAdd(&bar[XB_TMO], 1u); break; } }
    }
    nloc = mine > 0u ? mine : 1u; nx = cnt > 0u ? cnt : 1u;
}
__device__ __forceinline__ void xcd_barrier(const XcdBarrier& b) {
    asm volatile("s_waitcnt vmcnt(0)" ::: "memory");
    __syncthreads();
    if (threadIdx.x == 0) {
        unsigned* bar = b.bar;
        __builtin_amdgcn_s_waitcnt(0);
        unsigned nloc = b.st[0], nx = b.st[1];
        if (nloc == 0u) { xcd_barrier_complete(bar, b.x, nloc, nx); b.st[0] = nloc; b.st[1] = nx; }
        const unsigned old = xb_add(&bar[XB_XSUB(b.x)], 1u);
        const unsigned gen = old / nloc;
        if (old + 1u == (gen + 1u) * nloc) {
            __builtin_amdgcn_fence(__ATOMIC_RELEASE, "agent");
            asm volatile("s_waitcnt vmcnt(0)" ::: "memory");
            const unsigned og = xb_add(&bar[XB_TOP], 1u);
            const unsigned tg = og / nx;
            if (og + 1u == (tg + 1u) * nx) xb_add(&bar[XB_TOPGEN], 1u);
            else XB_SPIN(xb_ld(&bar[XB_TOPGEN]) == tg, bar);
            __builtin_amdgcn_fence(__ATOMIC_ACQUIRE, "agent");
            xb_add(&bar[XB_XGEN(b.x)], 1u);
            asm volatile("s_waitcnt vmcnt(0)" ::: "memory");
        } else {
            XB_SPIN(xb_ld(&bar[XB_XGEN(b.x)]) == gen, bar);
            __builtin_amdgcn_fence(__ATOMIC_ACQUIRE, "agent");
            asm volatile("s_waitcnt vmcnt(0)" ::: "memory");
        }
    }
    __syncthreads();
}

struct Args { const void* in[19]; float* out; unsigned char* ws; int ph_lo, ph_hi, li, pad; };
struct Frame {
    LAS unsigned char* lds; LAS int* lc;
    int tid, lane, wave, G, gw, NGW;
    const float *x, *c; const int* pos; const float *w_ada, *b_ada, *w_in, *b_forget, *w_out, *ln1_g, *ln1_b, *w_rg, *b_rg, *w_re, *b_re, *w_up, *w_gate, *w_down, *ln2_g, *ln2_b;
    float* out; unsigned char* ws;
};
__device__ __forceinline__ float wave_sum(float v) {
#pragma unroll
    for (int o = 1; o < 64; o <<= 1) v += __shfl_xor(v, o);
    return v;
}

__device__ __forceinline__ void transpose_item(const float* W, int ldw, int k0, int ncol0, bf16_t* WT, int ldt, int drow0, LAS float* scr, int lane) {
#pragma unroll 8
    for (int i = 0; i < 32; ++i) { const int kk = 2 * i + (lane >> 5); scr[kk * 33 + (lane & 31)] = W[(size_t)(k0 + kk) * ldw + ncol0 + (lane & 31)]; }
    LDS_WAIT(); asm volatile("" ::: "memory");
    const int c = lane & 7;
#pragma unroll
    for (int j = 0; j < 4; ++j) { const int n = (lane >> 3) + 8 * j; const LAS float* s = scr + (8 * c) * 33 + n;
        v4u o; o.x = pk2(s[0 * 33], s[1 * 33]); o.y = pk2(s[2 * 33], s[3 * 33]); o.z = pk2(s[4 * 33], s[5 * 33]); o.w = pk2(s[6 * 33], s[7 * 33]);
        *(GAS v4u*)(WT + (size_t)(drow0 + n) * ldt + k0 + 8 * c) = o; }
    LDS_WAIT(); asm volatile("" ::: "memory");
}
__device__ __forceinline__ void p0_prologue(Frame& F) {
    float* mod = (float*)(F.ws + WS_MOD);
    if (blockIdx.x < 192) {
        LAS float* sc = (LAS float*)F.lds; LAS float* red = (LAS float*)(F.lds + 32768);
        for (int i = F.tid; i < 8192; i += 512) { const float v = F.c[i]; sc[i] = v / (1.f + __expf(-v)); }
        __syncthreads();
        const int col = F.tid & 31, kp = F.tid >> 5, j = 32 * blockIdx.x + col;
        float acc[8];
#pragma unroll
        for (int b = 0; b < 8; ++b) acc[b] = 0.f;
#pragma unroll 8
        for (int kk = 0; kk < 64; ++kk) { const int k = kp * 64 + kk; const float w = F.w_ada[(size_t)k * 6144 + j];
#pragma unroll
            for (int b = 0; b < 8; ++b) acc[b] += sc[b * 1024 + k] * w; }
#pragma unroll
        for (int b = 0; b < 8; ++b) red[(kp * 8 + b) * 32 + col] = acc[b];
        __syncthreads();
        if (F.tid < 256) { const int b = F.tid >> 5; float s = 0.f;
#pragma unroll
            for (int q = 0; q < 16; ++q) s += red[(q * 8 + b) * 32 + col];
            mod[b * 6144 + j] = s + F.b_ada[j]; }
        __syncthreads();
    }
    LAS float* scr = (LAS float*)(F.lds + RING_OFF + F.wave * 16384);
    bf16_t* WIN = (bf16_t*)(F.ws + WS_WIN); bf16_t* WOUT = (bf16_t*)(F.ws + WS_WOUT); bf16_t* WGU = (bf16_t*)(F.ws + WS_WGU); bf16_t* WD = (bf16_t*)(F.ws + WS_WD);
    constexpr int I_IN = 16 * 112, I_OUT = 16 * 32, I_G = 32 * 16 * 16, I_D = 32 * 8 * 32, NITEMS = I_IN + I_OUT + 2 * I_G + I_D;
    for (int it = F.gw; it < NITEMS; it += F.NGW) {
        int r = it;
        if (r < I_IN) { const int kb = r / 112, nb = r % 112, n0 = 32 * nb; transpose_item(F.w_in, PROJ_LD, 64 * kb, n0 < 2048 ? n0 : n0 + 8, WIN, 1024, n0, scr, F.lane); continue; } r -= I_IN;
        if (r < I_OUT) { const int kb = r / 32, nb = r % 32; transpose_item(F.w_out, 1024, 64 * kb, 32 * nb, WOUT, 1024, 32 * nb, scr, F.lane); continue; } r -= I_OUT;
        if (r < 2 * I_G) { const int up = r >= I_G; if (up) r -= I_G; const int e = r >> 8, q = r & 255, kb = q >> 4, nb = q & 15, n0 = 32 * nb;
            transpose_item((up ? F.w_up : F.w_gate) + (size_t)e * 1024 * 512, 512, 64 * kb, n0, WGU + (size_t)e * 1024 * 1024, 1024, (n0 >> 7) * 256 + up * 128 + (n0 & 127), scr, F.lane); continue; } r -= 2 * I_G;
        { const int e = r >> 8, q = r & 255, kb = q >> 5, nb = q & 31; transpose_item(F.w_down + (size_t)e * 512 * 1024, 1024, 64 * kb, 32 * nb, WD + (size_t)e * 1024 * 512, 512, 32 * nb, scr, F.lane); }
    }
}

__device__ __forceinline__ void p1_hpass(Frame& F) {
    const float* mod = (const float*)(F.ws + WS_MOD); bf16_t* H = (bf16_t*)(F.ws + WS_H); float* logf = (float*)(F.ws + WS_LOGF); float* cs = (float*)(F.ws + WS_CS);
    LAS float* wff = (LAS float*)F.lds;
    for (int i = F.tid; i < 8192; i += 512) { const int k = i >> 3, h = i & 7; wff[h * 1024 + k] = F.w_in[(size_t)k * PROJ_LD + 2048 + h]; }
    __syncthreads();
    for (int m = F.gw; m < M; m += F.NGW) {
        const int b = m / S;
        const GAS f32x4* xr = (const GAS f32x4*)(F.x + (size_t)m * D) + F.lane;
        const GAS f32x4* sh = (const GAS f32x4*)(mod + b * 6144) + F.lane; const GAS f32x4* sc = (const GAS f32x4*)(mod + b * 6144 + 1024) + F.lane;
        float ff[8];
#pragma unroll
        for (int h = 0; h < 8; ++h) ff[h] = 0.f;
        GAS unsigned long long* o8 = (GAS unsigned long long*)(H + (size_t)m * D) + F.lane;
#pragma unroll
        for (int j = 0; j < 4; ++j) { const f32x4 xv = xr[64 * j], s1 = sc[64 * j], s0 = sh[64 * j]; const f32x4 hv = xv * (s1 + 1.0f) + s0;
            o8[64 * j] = (unsigned long long)pk2(hv.x, hv.y) | ((unsigned long long)pk2(hv.z, hv.w) << 32);
#pragma unroll
            for (int h = 0; h < 8; ++h) { const f32x4 w = *(const LAS f32x4*)(wff + h * 1024 + 4 * (64 * j + F.lane)); ff[h] += (hv.x * w.x + hv.y * w.y) + (hv.z * w.z + hv.w * w.w); } }
#pragma unroll
        for (int h = 0; h < 8; ++h) ff[h] = wave_sum(ff[h]);
        if (F.lane < 8) { float v = 0.f;
#pragma unroll
            for (int h = 0; h < 8; ++h) if (F.lane == h) v = ff[h];
            v += F.b_forget[F.lane];
            logf[(size_t)m * 8 + F.lane] = fminf(v, 0.f) - log1pf(__expf(-fabsf(v))); }
        if (F.lane >= 8 && F.lane < 16) { const int i = F.lane - 8; const float pos = (float)F.pos[m];
            const float invf = exp2f(-(float)i * 0.125f * 18.931568569324174f);
            const float ang = pos * invf;
            const double a = (double)ang; const double n = rint(a * 0.15915494309189535); const float r = (float)(a - n * 6.283185307179586);
            cs[(size_t)m * 16 + i] = __cosf(r); cs[(size_t)m * 16 + 8 + i] = __sinf(r); }
    }
}

__device__ __forceinline__ void p2_cum(Frame& F) {
    if (blockIdx.x >= 64) return;
    const float* logf = (const float*)(F.ws + WS_LOGF); float* cb = (float*)(F.ws + WS_CB);
    const int bh = blockIdx.x, b = bh >> 3, h = bh & 7, t = F.tid;
    LAS double* part = (LAS double*)F.lds;
    double v[8]; double s = 0.0;
#pragma unroll
    for (int i = 0; i < 8; ++i) { s += (double)logf[((size_t)b * S + t * 8 + i) * 8 + h]; v[i] = s; }
    part[t] = s; __syncthreads();
    for (int o = 1; o < 512; o <<= 1) { const double add = (t >= o) ? part[t - o] : 0.0; __syncthreads(); part[t] += add; __syncthreads(); }
    const double base = (t > 0) ? part[t - 1] : 0.0;
#pragma unroll
    for (int i = 0; i < 8; ++i) cb[(size_t)bh * S + t * 8 + i] = (float)(-(base + v[i]) * 1.4426950408889634);
    __syncthreads();
}

struct EpiProj {
    static constexpr bool PERM = true;
    bf16_t* base; const float* cs;
    __device__ __forceinline__ void operator()(const f32x4 (&acc)[2][2][4][2], const Unit& u, int wr, int wc, int fr, int fq) const {
        const int t = u.pn >> 1; bf16_t* O = (bf16_t*)((char*)base + (size_t)t * 32 * MiB);
        const int row0 = u.pm * 256 + wr * 64 + fr, col0 = (u.pn & 1) * 256 + wc * 32 + 8 * fq;
        const bool rope = (t == 4 || t == 5) && ((wc & 1) == 0);
        const float sc = (t == 0 || t == 4) ? C2 : 1.f;
#pragma unroll
        for (int ai = 0; ai < 2; ++ai)
#pragma unroll
            for (int m = 0; m < 4; ++m) { const int row = row0 + ai * 128 + m * 16; bf16_t* rowp = O + (size_t)row * GW + col0;
                f32x4 co0, co1, si0, si1;
                if (rope) { const f32x4* cp = (const f32x4*)(cs + (size_t)row * 16); co0 = cp[0]; co1 = cp[1]; si0 = cp[2]; si1 = cp[3]; }
#pragma unroll
                for (int bj = 0; bj < 2; ++bj) { f32x4 v0 = acc[ai][bj][m][0], v1 = acc[ai][bj][m][1];
                    if (rope) { f32x4 p0, p1;
#pragma unroll
                        for (int q = 0; q < 4; ++q) { p0[q] = __shfl_xor(v0[q], 16); p1[q] = __shfl_xor(v1[q], 16); }
                        if (fq == 0) { v0 = v0 * co0 - p0 * si0; v1 = v1 * co1 - p1 * si1; }
                        else if (fq == 1) { v0 = v0 * co0 + p0 * si0; v1 = v1 * co1 + p1 * si1; } }
                    if (t == 3) {
#pragma unroll
                        for (int q = 0; q < 4; ++q) { v0[q] = __builtin_amdgcn_rcpf(1.f + __expf(-v0[q])); v1[q] = __builtin_amdgcn_rcpf(1.f + __expf(-v1[q])); } }
                    v0 = v0 * sc; v1 = v1 * sc;
                    pg8::u32x4 w; w.x = pg8::cvt_pk_bf16(v0[0], v0[1]); w.y = pg8::cvt_pk_bf16(v0[2], v0[3]); w.z = pg8::cvt_pk_bf16(v1[0], v1[1]); w.w = pg8::cvt_pk_bf16(v1[2], v1[3]);
                    *(pg8::u32x4*)(rowp + bj * 128) = w; } }
    }
};
struct EpiF32 {
    static constexpr bool PERM = false;
    float* C; long long ldc;
    __device__ __forceinline__ void operator()(const f32x4 (&acc)[2][2][4][2], const Unit& u, int wr, int wc, int fr, int fq) const {
        const int row0 = u.pm * 256 + wr * 64 + fr, col0 = u.pn * 256 + wc * 32 + 4 * fq;
#pragma unroll
        for (int ai = 0; ai < 2; ++ai)
#pragma unroll
            for (int m = 0; m < 4; ++m) { float* rowp = C + (size_t)(row0 + ai * 128 + m * 16) * ldc + col0;
#pragma unroll
                for (int bj = 0; bj < 2; ++bj)
#pragma unroll
                    for (int n = 0; n < 2; ++n) *(f32x4*)(rowp + bj * 128 + n * 16) = acc[ai][bj][m][n]; }
    }
};
struct EpiSwiglu {
    static constexpr bool PERM = true;
    bf16_t* O;
    __device__ __forceinline__ void operator()(const f32x4 (&acc)[2][2][4][2], const Unit& u, int wr, int wc, int fr, int fq) const {
        const int row0 = u.pm * 256 + wr * 64 + fr, col0 = u.pn * 128 + wc * 32 + 8 * fq;
#pragma unroll
        for (int ai = 0; ai < 2; ++ai)
#pragma unroll
            for (int m = 0; m < 4; ++m) { bf16_t* rowp = O + (size_t)(row0 + ai * 128 + m * 16) * DE + col0;
                f32x4 r[2];
#pragma unroll
                for (int n = 0; n < 2; ++n) { const f32x4 g = acc[ai][0][m][n], up = acc[ai][1][m][n];
#pragma unroll
                    for (int q = 0; q < 4; ++q) r[n][q] = g[q] * __builtin_amdgcn_rcpf(1.f + __expf(-g[q])) * up[q]; }
                pg8::u32x4 w; w.x = pg8::cvt_pk_bf16(r[0][0], r[0][1]); w.y = pg8::cvt_pk_bf16(r[0][2], r[0][3]); w.z = pg8::cvt_pk_bf16(r[1][0], r[1][1]); w.w = pg8::cvt_pk_bf16(r[1][2], r[1][3]);
                *(pg8::u32x4*)rowp = w; }
    }
};
struct EpiBf16 {
    static constexpr bool PERM = true;
    bf16_t* O; long long ldc;
    __device__ __forceinline__ void operator()(const f32x4 (&acc)[2][2][4][2], const Unit& u, int wr, int wc, int fr, int fq) const {
        const int row0 = u.pm * 256 + wr * 64 + fr, col0 = u.pn * 256 + wc * 32 + 8 * fq;
#pragma unroll
        for (int ai = 0; ai < 2; ++ai)
#pragma unroll
            for (int m = 0; m < 4; ++m) { bf16_t* rowp = O + (size_t)(row0 + ai * 128 + m * 16) * ldc + col0;
#pragma unroll
                for (int bj = 0; bj < 2; ++bj) { const f32x4 v0 = acc[ai][bj][m][0], v1 = acc[ai][bj][m][1];
                    pg8::u32x4 w; w.x = pg8::cvt_pk_bf16(v0[0], v0[1]); w.y = pg8::cvt_pk_bf16(v0[2], v0[3]); w.z = pg8::cvt_pk_bf16(v1[0], v1[1]); w.w = pg8::cvt_pk_bf16(v1[2], v1[3]);
                    *(pg8::u32x4*)(rowp + bj * 128) = w; } }
    }
};

__device__ __forceinline__ float dot2c(unsigned a, unsigned b, float acc) { asm volatile("v_dot2c_f32_bf16 %0, %1, %2" : "+v"(acc) : "v"(a), "v"(b)); return acc; }
__device__ __forceinline__ void p6_ln1_router(Frame& F) {
    const float* mod = (const float*)(F.ws + WS_MOD); const float* y1 = (const float*)(F.ws + WS_FQ); bf16_t* H2 = (bf16_t*)(F.ws + WS_H);
    float* topw = (float*)(F.ws + WS_TOPW); int* slotpos = (int*)(F.ws + WS_SLOTPOS); int* list = (int*)(F.ws + WS_LIST); unsigned* gcnt = (unsigned*)(F.ws + WS_CTL) + CW_CNT;
    LAS v4u* WR = (LAS v4u*)F.lds;
    LAS int* eid = (LAS int*)(F.lds + 73728);
    LAS float* ewt = (LAS float*)(F.lds + 73728 + 1024);
    LAS int* hist = F.lc + LC_HIST; LAS int* base = F.lc + LC_BASE;
    LAS bf16_t* WRh = (LAS bf16_t*)F.lds;
    for (int idx = F.tid; idx < 36 * 1024; idx += 512) { const int k = idx / 36, i = idx % 36; const float w = (i < 4) ? F.w_rg[k * 4 + i] : F.w_re[k * 32 + (i - 4)];
        const int q = k & 3, kl = k >> 2, lane = kl & 63, j = kl >> 6;
        WRh[(((i * 2 + (j >> 1)) * 64 + lane) * 16 + (j & 1) * 8 + q * 2) >> 1] = f2bf(w); }
    __syncthreads();
    for (int ch = blockIdx.x; ch < M / 128; ch += F.G) {
        if (F.tid < 32) hist[F.tid] = 0;
        for (int rr = 0; rr < 16; ++rr) {
            const int lr = F.wave * 16 + rr, m = ch * 128 + lr, b = m / S;
            const GAS f32x4* xr = (const GAS f32x4*)(F.x + (size_t)m * D) + F.lane; const GAS f32x4* yr = (const GAS f32x4*)(y1 + (size_t)m * D) + F.lane;
            const GAS f32x4* gate = (const GAS f32x4*)(mod + b * 6144 + 2048) + F.lane; const GAS f32x4* sh2 = (const GAS f32x4*)(mod + b * 6144 + 3072) + F.lane; const GAS f32x4* sc2 = (const GAS f32x4*)(mod + b * 6144 + 4096) + F.lane;
            const GAS f32x4* g1 = (const GAS f32x4*)F.ln1_g + F.lane; const GAS f32x4* b1 = (const GAS f32x4*)F.ln1_b + F.lane;
            f32x4 v[4]; float s = 0.f;
#pragma unroll
            for (int j = 0; j < 4; ++j) { v[j] = xr[64 * j] * ALPHA + gate[64 * j] * yr[64 * j]; s += (v[j].x + v[j].y) + (v[j].z + v[j].w); }
            const float mean = wave_sum(s) * (1.f / D); float q = 0.f;
#pragma unroll
            for (int j = 0; j < 4; ++j) { v[j] = v[j] - mean; q += (v[j].x * v[j].x + v[j].y * v[j].y) + (v[j].z * v[j].z + v[j].w * v[j].w); }
            const float rstd = 1.f / sqrtf(wave_sum(q) * (1.f / D) + LN_EPS);
            unsigned hb[4][2];
            GAS f32x4* xo = (GAS f32x4*)(F.out + (size_t)m * D) + F.lane; GAS unsigned long long* ho = (GAS unsigned long long*)(H2 + (size_t)m * D) + F.lane;
#pragma unroll
            for (int j = 0; j < 4; ++j) { const f32x4 x1 = v[j] * rstd * g1[64 * j] + b1[64 * j]; xo[64 * j] = x1;
                const f32x4 h2 = x1 * (sc2[64 * j] + 1.0f) + sh2[64 * j]; hb[j][0] = pk2(h2.x, h2.y); hb[j][1] = pk2(h2.z, h2.w);
                ho[64 * j] = (unsigned long long)hb[j][0] | ((unsigned long long)hb[j][1] << 32); }
            float lg[36];
#pragma unroll
            for (int i = 0; i < 36; ++i) { float a = 0.f;
#pragma unroll
                for (int jp = 0; jp < 2; ++jp) { const v4u w = WR[(i * 2 + jp) * 64 + F.lane];
                    a = dot2c(hb[2 * jp][0], w.x, a); a = dot2c(hb[2 * jp][1], w.y, a); a = dot2c(hb[2 * jp + 1][0], w.z, a); a = dot2c(hb[2 * jp + 1][1], w.w, a); }
                lg[i] = wave_sum(a); }
            float gl[4]; int g = 0;
#pragma unroll
            for (int i = 0; i < 4; ++i) gl[i] = lg[i] + F.b_rg[i];
            float gbest = gl[0];
#pragma unroll
            for (int i = 1; i < 4; ++i) if (gl[i] > gbest) { gbest = gl[i]; g = i; }
            float den = 0.f;
#pragma unroll
            for (int i = 0; i < 4; ++i) den += __expf(gl[i] - gbest);
            const float pg = 1.f / den;
            float el[8];
#pragma unroll
            for (int i = 0; i < 8; ++i) { float vv = 0.f;
#pragma unroll
                for (int gg = 0; gg < 4; ++gg) if (gg == g) vv = lg[4 + gg * 8 + i] + F.b_re[gg * 8 + i];
                el[i] = vv; }
            int i1 = 0; float v1 = el[0];
#pragma unroll
            for (int i = 1; i < 8; ++i) if (el[i] > v1) { v1 = el[i]; i1 = i; }
            int i2 = 0; float v2 = -INFINITY;
#pragma unroll
            for (int i = 0; i < 8; ++i) if (i != i1 && el[i] > v2) { v2 = el[i]; i2 = i; }
            const float e2 = __expf(v2 - v1); const float w1 = pg / (1.f + e2), w2 = pg * e2 / (1.f + e2);
            if (F.lane == 0) { eid[lr * 2] = g * 8 + i1; eid[lr * 2 + 1] = g * 8 + i2; ewt[lr * 2] = w1; ewt[lr * 2 + 1] = w2; }
        }
        __syncthreads();
        int e = 0, rank = 0;
        if (F.tid < 256) { e = eid[F.tid]; rank = __hip_atomic_fetch_add(hist + e, 1, __ATOMIC_RELAXED, __HIP_MEMORY_SCOPE_WORKGROUP); }
        __syncthreads();
        if (F.tid < 32) base[F.tid] = (int)__hip_atomic_fetch_add(gcnt + F.tid, (unsigned)hist[F.tid], __ATOMIC_RELAXED, __HIP_MEMORY_SCOPE_AGENT);
        __syncthreads();
        if (F.tid < 256) { const int p = base[e] + rank, tok = ch * 128 + (F.tid >> 1); list[(size_t)e * LCAP + p] = tok; slotpos[tok * 2 + (F.tid & 1)] = e * LCAP + p; topw[tok * 2 + (F.tid & 1)] = ewt[F.tid]; }
        __syncthreads();
    }
}

__device__ __forceinline__ void moe_offsets(Frame& F) {
    const unsigned* gcnt = (const unsigned*)(F.ws + WS_CTL) + CW_CNT;
    if (F.tid < 32) F.lc[LC_CNT + F.tid] = (int)__hip_atomic_load(gcnt + F.tid, RLX_AGENT);
    __syncthreads();
    if (F.tid == 0) { int p = 0; for (int e = 0; e < 32; ++e) { F.lc[LC_POFF + e] = p; p += (F.lc[LC_CNT + e] + MOEB - 1) / MOEB * MOEB; } F.lc[LC_POFF + 32] = p; }
    __syncthreads();
}

__device__ __forceinline__ void p9_final(Frame& F) {
    const float* mod = (const float*)(F.ws + WS_MOD); const bf16_t* Y = (const bf16_t*)(F.ws + WS_Y);
    const float* topw = (const float*)(F.ws + WS_TOPW); const int* slotpos = (const int*)(F.ws + WS_SLOTPOS);
    for (int m = F.gw; m < M; m += F.NGW) {
        const int b = m / S;
        const int sp0 = slotpos[m * 2], sp1 = slotpos[m * 2 + 1]; const float w0 = topw[m * 2], w1 = topw[m * 2 + 1];
        const int s0 = F.lc[LC_POFF + (sp0 >> 15)] + (sp0 & (LCAP - 1)), s1 = F.lc[LC_POFF + (sp1 >> 15)] + (sp1 & (LCAP - 1));
        GAS f32x4* xr = (GAS f32x4*)(F.out + (size_t)m * D) + F.lane; const GAS f32x4* gate = (const GAS f32x4*)(mod + b * 6144 + 5120) + F.lane;
        const GAS v2u* y0 = (const GAS v2u*)(Y + (size_t)s0 * D) + F.lane; const GAS v2u* y1 = (const GAS v2u*)(Y + (size_t)s1 * D) + F.lane;
        const GAS f32x4* g2 = (const GAS f32x4*)F.ln2_g + F.lane; const GAS f32x4* b2 = (const GAS f32x4*)F.ln2_b + F.lane;
        f32x4 v[4]; float s = 0.f;
#pragma unroll
        for (int j = 0; j < 4; ++j) { const v2u a = y0[64 * j], c = y1[64 * j];
            f32x4 y; y.x = w0 * bf2f((bf16_t)(a.x & 0xffff)) + w1 * bf2f((bf16_t)(c.x & 0xffff)); y.y = w0 * bf2f((bf16_t)(a.x >> 16)) + w1 * bf2f((bf16_t)(c.x >> 16));
            y.z = w0 * bf2f((bf16_t)(a.y & 0xffff)) + w1 * bf2f((bf16_t)(c.y & 0xffff)); y.w = w0 * bf2f((bf16_t)(a.y >> 16)) + w1 * bf2f((bf16_t)(c.y >> 16));
            v[j] = xr[64 * j] * ALPHA + gate[64 * j] * y; s += (v[j].x + v[j].y) + (v[j].z + v[j].w); }
        const float mean = wave_sum(s) * (1.f / D); float q = 0.f;
#pragma unroll
        for (int j = 0; j < 4; ++j) { v[j] = v[j] - mean; q += (v[j].x * v[j].x + v[j].y * v[j].y) + (v[j].z * v[j].z + v[j].w * v[j].w); }
        const float rstd = 1.f / sqrtf(wave_sum(q) * (1.f / D) + LN_EPS);
#pragma unroll
        for (int j = 0; j < 4; ++j) xr[64 * j] = v[j] * rstd * g2[64 * j] + b2[64 * j];
    }
}
}
#ifndef MIX_GOLD_ATTN
#define MIX_GOLD_ATTN 0
#endif
#include <hip/hip_bf16.h>
#include <cmath>
namespace attn_body {
using bf16=__hip_bfloat16;
using bf16x8=__attribute__((ext_vector_type(8)))short;
using s16x4=__attribute__((ext_vector_type(4)))short;
using f32x16=__attribute__((ext_vector_type(16)))float;
using u32x4=__attribute__((ext_vector_type(4)))unsigned;
constexpr int BATCH=8,NHEAD=8,SEQ=4096,D=64,DM=NHEAD*D,DMO=1024;
constexpr int NW=8,QBLK=32,QB=QBLK*NW,KVBLK=64,NQB=SEQ/QB;
constexpr int ATTN_PITCH=DM, ATTN_UNIT_ROWS=QB;
__device__ __forceinline__ int crow(int r,int hi){return (r&3)+8*(r>>2)+4*hi;}
#define SBAR() __builtin_amdgcn_sched_barrier(0)
__device__ __forceinline__ void cmask(f32x16&p0,f32x16&p1,int jb,int qrel,int hi){
  const float NEG=-INFINITY; int kb=64*jb+4*hi;
  #pragma unroll
  for(int r=0;r<16;++r){int kv=kb+(r&3)+8*(r>>2); if(kv>qrel)p0[r]=NEG; if(kv+32>qrel)p1[r]=NEG;}
}

constexpr int NSLOT=3, SLOTB=8192;
constexpr int LDS_K=0, LDS_V=NSLOT*SLOTB, LDS_WS=2*NSLOT*SLOTB, LDS_OST=LDS_WS+NW*128*4, LDS_CB=LDS_OST+NW*4096, LDS_BYTES=LDS_CB+SEQ*4;
constexpr float C2=0.125f*1.4426950408889634f;
__device__ __forceinline__ void glds16(const void*gsrc,unsigned lds_dst){unsigned keep;
  asm volatile("s_mov_b32 %0, m0\n\ts_mov_b32 m0, %2\n\ts_nop 0\n\tglobal_load_lds_dwordx4 %1, off\n\ts_mov_b32 m0, %0":"=&s"(keep):"v"(gsrc),"s"(lds_dst):"memory");}
__device__ __forceinline__ float max3f(float a,float b,float c){float r;asm("v_max3_f32 %0, %1, %2, %3":"=v"(r):"v"(a),"v"(b),"v"(c));return r;}
__device__ __forceinline__ float max2f(float a,float b){float r;asm("v_max_f32_e32 %0, %1, %2":"=v"(r):"v"(a),"v"(b));return r;}
__device__ __forceinline__ float fadd_s(float a,float b){float r;asm("v_add_f32_e32 %0, %1, %2":"=v"(r):"v"(a),"v"(b));return r;}
__device__ __forceinline__ float fsub_s(float a,float b){float r;asm("v_sub_f32_e32 %0, %1, %2":"=v"(r):"v"(a),"v"(b));return r;}
typedef float f32x2_t __attribute__((ext_vector_type(2))); typedef __bf16 bf16x2_t __attribute__((ext_vector_type(2)));
__device__ __forceinline__ unsigned cvtpk_s(float lo,float hi){f32x2_t v={lo,hi};bf16x2_t b=__builtin_convertvector(v,bf16x2_t);return __builtin_bit_cast(unsigned,b);}
#define WAIT_BAR(N) asm volatile("s_waitcnt vmcnt(" #N ") lgkmcnt(0)\n\ts_barrier":::"memory")

__device__ __forceinline__ void qkt(f32x16&p0,f32x16&p1,const char*Kslot,const bf16x8*qr,const f32x16&negm,int r32,int hi){
  const char*kb=Kslot+hi*1024+r32*16;
  #pragma unroll
  for(int d0=0;d0<4;++d0){
    const bf16x8 b0=*reinterpret_cast<const bf16x8*>(kb+d0*2048);
    const bf16x8 b1=*reinterpret_cast<const bf16x8*>(kb+d0*2048+512);
    if(d0==0){p0=__builtin_amdgcn_mfma_f32_32x32x16_bf16(b0,qr[0],negm,0,0,0);p1=__builtin_amdgcn_mfma_f32_32x32x16_bf16(b1,qr[0],negm,0,0,0);}
    else{p0=__builtin_amdgcn_mfma_f32_32x32x16_bf16(b0,qr[d0],p0,0,0,0);p1=__builtin_amdgcn_mfma_f32_32x32x16_bf16(b1,qr[d0],p1,0,0,0);}}
}
typedef __attribute__((address_space(3))) const char* lds_cptr;
typedef short v4i16_t __attribute__((ext_vector_type(4)));
__device__ __forceinline__ void kload8(bf16x8*kf,lds_cptr kp){
  kf[0]=*(const __attribute__((address_space(3))) bf16x8*)(kp);      kf[1]=*(const __attribute__((address_space(3))) bf16x8*)(kp+512);
  kf[2]=*(const __attribute__((address_space(3))) bf16x8*)(kp+2048); kf[3]=*(const __attribute__((address_space(3))) bf16x8*)(kp+2560);
  kf[4]=*(const __attribute__((address_space(3))) bf16x8*)(kp+4096); kf[5]=*(const __attribute__((address_space(3))) bf16x8*)(kp+4608);
  kf[6]=*(const __attribute__((address_space(3))) bf16x8*)(kp+6144); kf[7]=*(const __attribute__((address_space(3))) bf16x8*)(kp+6656);
}
__device__ __forceinline__ void kload2(bf16x8*kf,lds_cptr kp,int j){ kf[2*j]=*(const __attribute__((address_space(3))) bf16x8*)(kp+j*2048); kf[2*j+1]=*(const __attribute__((address_space(3))) bf16x8*)(kp+j*2048+512); }
__device__ __forceinline__ s16x4 vtr(lds_cptr p){ return __builtin_bit_cast(s16x4,__builtin_amdgcn_ds_read_tr16_b64_v4i16((__attribute__((address_space(3))) v4i16_t*)p)); }
__device__ __forceinline__ float rowmax(const f32x16&p0,const f32x16&p1){
  float a=max3f(p0[0],p0[1],p1[0]),b=max3f(p0[2],p0[3],p1[1]);a=max3f(a,p1[2],p1[3]);
  #pragma unroll
  for(int r=4;r<16;r+=4){a=max3f(a,p0[r],p0[r+1]);b=max3f(b,p0[r+2],p0[r+3]);a=max3f(a,p1[r],p1[r+1]);b=max3f(b,p1[r+2],p1[r+3]);}
  const float m=max2f(a,b);
  auto rr=__builtin_amdgcn_permlane32_swap(__float_as_uint(m),__float_as_uint(m),false,false);
  return max2f(__uint_as_float(rr[0]),__uint_as_float(rr[1]));
}
__device__ __forceinline__ void pv(f32x16*o,int vb,bf16x8 pa0,bf16x8 pa1,bf16x8 pa2,bf16x8 pa3){
  #pragma unroll
  for(int d0=0;d0<2;++d0){s16x4 lo[4],hi[4];
    #pragma unroll
    for(int ks=0;ks<4;++ks){
      asm volatile("ds_read_b64_tr_b16 %0,%1 offset:%c2":"=&v"(lo[ks]):"v"(vb),"i"(d0*4096+ks*1024):"memory");
      asm volatile("ds_read_b64_tr_b16 %0,%1 offset:%c2":"=&v"(hi[ks]):"v"(vb),"i"(d0*4096+ks*1024+512):"memory");}
    asm volatile("s_waitcnt lgkmcnt(0)":::"memory");SBAR();
    #define PK(k) (bf16x8){lo[k][0],lo[k][1],lo[k][2],lo[k][3],hi[k][0],hi[k][1],hi[k][2],hi[k][3]}
    o[d0]=__builtin_amdgcn_mfma_f32_32x32x16_bf16(pa0,PK(0),o[d0],0,0,0);
    o[d0]=__builtin_amdgcn_mfma_f32_32x32x16_bf16(pa1,PK(1),o[d0],0,0,0);
    o[d0]=__builtin_amdgcn_mfma_f32_32x32x16_bf16(pa2,PK(2),o[d0],0,0,0);
    o[d0]=__builtin_amdgcn_mfma_f32_32x32x16_bf16(pa3,PK(3),o[d0],0,0,0);
    #undef PK
  }
}

typedef float f32x4v __attribute__((ext_vector_type(4)));
typedef __attribute__((address_space(3))) const f32x4v* lds_f4ptr;
constexpr int ATTN_LDS_BYTES=LDS_BYTES;
struct AttnTensors { const bf16* Q; const bf16* K; const bf16* V; const bf16* G; const float* CB; bf16* O; };
constexpr float DNEG = -1.0e30f;
__device__ __forceinline__ void qkt_l(f32x16&p0,f32x16&p1,lds_cptr kb,const bf16x8*qr,const f32x16&negm){
  #pragma unroll
  for(int d0=0;d0<4;++d0){
    const bf16x8 b0=*(const __attribute__((address_space(3))) bf16x8*)(kb+d0*2048);
    const bf16x8 b1=*(const __attribute__((address_space(3))) bf16x8*)(kb+d0*2048+512);
    if(d0==0){p0=__builtin_amdgcn_mfma_f32_32x32x16_bf16(b0,qr[0],negm,0,0,0);p1=__builtin_amdgcn_mfma_f32_32x32x16_bf16(b1,qr[0],negm,0,0,0);}
    else{p0=__builtin_amdgcn_mfma_f32_32x32x16_bf16(b0,qr[d0],p0,0,0,0);p1=__builtin_amdgcn_mfma_f32_32x32x16_bf16(b1,qr[d0],p1,0,0,0);}}
}
template<int KIND> __device__ __forceinline__ void dil_unit(int b,int h,int d,int r,int ublk,const bf16*Q,const bf16*__restrict__ K,const bf16*__restrict__ V,
    bf16*OP,float*LP,const bf16*PA,const float*LA,const bf16*PB,const float*LB,bf16*MG,const bf16*__restrict__ G,const float*__restrict__ CB,char*shm){
  constexpr int MODE=(KIND==2)?1:0; constexpr bool FOX=(KIND==0);
  const int tid=threadIdx.x,lane=tid&63,r32=lane&31,hi=lane>>5; const int wid=__builtin_amdgcn_readfirstlane(tid>>6);
  const long rowbase=(long)b*SEQ; const int m0=ublk*QB;
  const bf16*Kh=K+rowbase*DM+h*D,*Vh=V+rowbase*DM+h*D;
  const unsigned lds0=(unsigned)(uintptr_t)shm;
  float*wsf=(float*)(shm+LDS_WS)+wid*128;
  const int jlo=FOX?-4*ublk:((ublk==0)?0:-2), nT=4-jlo;
  const unsigned kdst=lds0+LDS_K+wid*1024, vdst=lds0+LDS_V+wid*1024;
  #define DKSRC(j) (Kh+((long)(m0+64*(j)+lane)*d+r)*DM+wid*8)
  #define DVSRC(j) (Vh+((long)(m0+64*(j)+16*(wid&3)+(lane>>2))*d+r)*DM+(wid>>2)*32+(lane&3)*8)
  #define DDMA(j,slot) do{ glds16(DKSRC(j),(unsigned)__builtin_amdgcn_readfirstlane(kdst+(slot))); glds16(DVSRC(j),(unsigned)__builtin_amdgcn_readfirstlane(vdst+(slot))); }while(0)
  if(FOX){ const f32x4v*cbg=(const f32x4v*)(CB+(long)(b*NHEAD+h)*SEQ); __attribute__((address_space(3))) f32x4v*cbl=(__attribute__((address_space(3))) f32x4v*)(shm+LDS_CB);
    for(int i=tid;i<(m0+QB)/4;i+=NW*64)cbl[i]=cbg[i]; }
  const lds_f4ptr cbl4=(lds_f4ptr)(shm+LDS_CB)+hi;
  bf16x8 qr[4];
  { const bf16*Qw=Q+(rowbase+(long)(m0+wid*QBLK+r32)*d+r)*DM+h*D;
    #pragma unroll
    for(int d0=0;d0<4;++d0)qr[d0]=*reinterpret_cast<const bf16x8*>(&Qw[d0*16+hi*8]); }
  DDMA(jlo,0); DDMA(jlo+1,SLOTB);
  const lds_cptr shm3=(lds_cptr)shm; const lds_cptr kp0=shm3+LDS_K+hi*1024+r32*16;
  const int vb0=(int)(lds0+LDS_V)+((lane>>4)&1)*32+(lane&3)*8+(4*hi+((lane&15)>>2))*64;
  float mhat=0.f,l_reg=0.f; f32x16 o[2]; o[0]=f32x16{}; o[1]=f32x16{}; f32x16 negm=f32x16{};
  bool started=false; const int qrel=wid*QBLK+r32;
  int slot=0, slot2=2*SLOTB;
  for(int s=0;s<nT;++s){
    const int j=jlo+s;
    if(s+1<nT){WAIT_BAR(2);}else{WAIT_BAR(0);}
    if(s+2<nT){DDMA(j+2,slot2);}
    const bool active=(FOX||(64*j+63>=32*wid-128))&&(64*j<=32*wid+31);
    if(active){
      f32x16 p0,p1;
      qkt_l(p0,p1,kp0+slot,qr,negm);
      if(FOX){ const lds_f4ptr bp_=cbl4+(4*ublk+j)*16;
        #pragma unroll
        for(int g_=0;g_<4;++g_){ const f32x4v b0_=bp_[2*g_], b1_=bp_[8+2*g_];
          p0[4*g_]+=b0_.x;p0[4*g_+1]+=b0_.y;p0[4*g_+2]+=b0_.z;p0[4*g_+3]+=b0_.w; p1[4*g_]+=b1_.x;p1[4*g_+1]+=b1_.y;p1[4*g_+2]+=b1_.z;p1[4*g_+3]+=b1_.w; } }
      if(64*j+63>32*wid){ const int kb=64*j+4*hi;
        #pragma unroll
        for(int rr=0;rr<16;++rr){const int kv=kb+(rr&3)+8*(rr>>2); if(kv>qrel)p0[rr]=DNEG; if(kv+32>qrel)p1[rr]=DNEG;} }
      if(!FOX&&64*j<32*wid+31-128){ const int kb=64*j+4*hi+128;
        #pragma unroll
        for(int rr=0;rr<16;++rr){const int kv=kb+(rr&3)+8*(rr>>2); if(kv<qrel)p0[rr]=DNEG; if(kv+32<qrel)p1[rr]=DNEG;} }
      float a=__builtin_fmaxf(__builtin_fmaxf(p0[0],p0[1]),p1[0]),bq=__builtin_fmaxf(__builtin_fmaxf(p0[2],p0[3]),p1[1]); a=__builtin_fmaxf(__builtin_fmaxf(a,p1[2]),p1[3]);
      #pragma unroll
      for(int rr=4;rr<16;rr+=4){a=__builtin_fmaxf(__builtin_fmaxf(a,p0[rr]),p0[rr+1]);bq=__builtin_fmaxf(__builtin_fmaxf(bq,p0[rr+2]),p0[rr+3]);a=__builtin_fmaxf(__builtin_fmaxf(a,p1[rr]),p1[rr+1]);bq=__builtin_fmaxf(__builtin_fmaxf(bq,p1[rr+2]),p1[rr+3]);}
      float rm=__builtin_fmaxf(a,bq); { auto sw=__builtin_amdgcn_permlane32_swap(__float_as_uint(rm),__float_as_uint(rm),false,false); rm=__builtin_fmaxf(__uint_as_float(sw[0]),__uint_as_float(sw[1])); }
      if(!started){ started=true; mhat=rm;
        #pragma unroll
        for(int rr=0;rr<16;++rr){p0[rr]-=rm;p1[rr]-=rm;}
        #pragma unroll
        for(int rr=0;rr<16;++rr)negm[rr]=-mhat;
      } else if(__any(rm>(FOX?8.0f:4.0f))){ const float dl=__builtin_fmaxf(rm,0.f); mhat+=dl;
        #pragma unroll
        for(int rr=0;rr<16;++rr){p0[rr]-=dl;p1[rr]-=dl;}
        #pragma unroll
        for(int rr=0;rr<16;++rr)negm[rr]=-mhat;
        const float f=__builtin_amdgcn_exp2f(-dl); l_reg*=f; if(hi==0)wsf[r32]=f;
        asm volatile("s_waitcnt lgkmcnt(0)":::"memory");
        #pragma unroll
        for(int d_=0;d_<2;++d_)
          #pragma unroll
          for(int rr=0;rr<16;++rr)o[d_][rr]*=wsf[crow(rr,hi)];
      }
      float sacc=0.f;
      #pragma unroll
      for(int rr=0;rr<16;++rr){p0[rr]=__builtin_amdgcn_exp2f(p0[rr]);p1[rr]=__builtin_amdgcn_exp2f(p1[rr]);sacc+=p0[rr]+p1[rr];}
      l_reg+=sacc;
      u32x4 pw0,pw1,pw2,pw3;
      pw0=(u32x4){cvtpk_s(p0[0],p0[1]),cvtpk_s(p0[2],p0[3]),cvtpk_s(p0[4],p0[5]),cvtpk_s(p0[6],p0[7])};
      pw1=(u32x4){cvtpk_s(p0[8],p0[9]),cvtpk_s(p0[10],p0[11]),cvtpk_s(p0[12],p0[13]),cvtpk_s(p0[14],p0[15])};
      pw2=(u32x4){cvtpk_s(p1[0],p1[1]),cvtpk_s(p1[2],p1[3]),cvtpk_s(p1[4],p1[5]),cvtpk_s(p1[6],p1[7])};
      pw3=(u32x4){cvtpk_s(p1[8],p1[9]),cvtpk_s(p1[10],p1[11]),cvtpk_s(p1[12],p1[13]),cvtpk_s(p1[14],p1[15])};
      SBAR();
      pv(o,vb0+slot,__builtin_bit_cast(bf16x8,pw0),__builtin_bit_cast(bf16x8,pw1),__builtin_bit_cast(bf16x8,pw2),__builtin_bit_cast(bf16x8,pw3));
    }
    slot=(slot==2*SLOTB)?0:slot+SLOTB; slot2=(slot2==2*SLOTB)?0:slot2+SLOTB;
  }
  {auto sw=__builtin_amdgcn_permlane32_swap(__float_as_uint(l_reg),__float_as_uint(l_reg),false,false);l_reg=__uint_as_float(sw[0])+__uint_as_float(sw[1]);}
  const float lse=mhat+__builtin_amdgcn_logf(l_reg);
  if(hi==0){wsf[32+r32]=l_reg;wsf[64+r32]=lse;} asm volatile("s_waitcnt lgkmcnt(0)":::"memory");
  float rli[16];
  #pragma unroll
  for(int rr=0;rr<16;++rr)rli[rr]=__builtin_amdgcn_rcpf(wsf[32+crow(rr,hi)]);
  { bf16*stg=(bf16*)(shm+LDS_OST)+wid*2048;
    #pragma unroll
    for(int rr=0;rr<16;++rr){const int orow=crow(rr,hi);
      #pragma unroll
      for(int d0=0;d0<2;++d0)stg[orow*64+d0*32+r32]=__float2bfloat16(o[d0][rr]*rli[rr]);}
    asm volatile("s_waitcnt lgkmcnt(0)":::"memory");
    #pragma unroll
    for(int i=0;i<4;++i){const int row=i*8+(lane>>3),ch=lane&7; const u32x4 v=*(const u32x4*)(stg+row*64+ch*8);
      const long grow=rowbase+(long)(m0+wid*QBLK+row)*d+r;
      if(FOX){ const u32x4 g=*(const u32x4*)(G+grow*DM+h*D+ch*8); u32x4 w;
        #pragma unroll
        for(int c=0;c<4;++c){ const float a0=__uint_as_float(v[c]<<16)*__uint_as_float(g[c]<<16), a1=__uint_as_float(v[c]&0xffff0000u)*__uint_as_float(g[c]&0xffff0000u); w[c]=cvtpk_s(a0,a1); }
        *(u32x4*)(MG+grow*DMO+h*D+ch*8)=w; }
      else if(MODE==0){ *(u32x4*)(OP+grow*DM+h*D+ch*8)=v; if(ch==0)LP[grow*NHEAD+h]=wsf[64+row]; }
      else { const u32x4 va=*(const u32x4*)(PA+grow*DM+h*D+ch*8), vb=*(const u32x4*)(PB+grow*DM+h*D+ch*8); const float la=LA[grow*NHEAD+h], lb=LB[grow*NHEAD+h], lc=wsf[64+row];
        const float mx=__builtin_fmaxf(__builtin_fmaxf(la,lb),lc); const float wa=__builtin_amdgcn_exp2f(la-mx), wb=__builtin_amdgcn_exp2f(lb-mx), wc=__builtin_amdgcn_exp2f(lc-mx); const float inv=__builtin_amdgcn_rcpf(wa+wb+wc);
        u32x4 w;
        #pragma unroll
        for(int c=0;c<4;++c){ const float x0=(wa*__uint_as_float(va[c]<<16)+wb*__uint_as_float(vb[c]<<16)+wc*__uint_as_float(v[c]<<16))*inv;
          const float x1=(wa*__uint_as_float(va[c]&0xffff0000u)+wb*__uint_as_float(vb[c]&0xffff0000u)+wc*__uint_as_float(v[c]&0xffff0000u))*inv; w[c]=cvtpk_s(x0,x1); }
        *(u32x4*)(MG+grow*DMO+512+h*D+ch*8)=w; } } }
  asm volatile("s_waitcnt lgkmcnt(0)\n\ts_barrier":::"memory");
  #undef DKSRC
  #undef DVSRC
  #undef DDMA
}
#undef SBAR
#undef WAIT_BAR
}

namespace mk {
__device__ __forceinline__ void p3_attn(Frame& F, char* lds) {
    typedef attn_body::bf16 abf;
    const int vcu = (F.G % 8 == 0) ? ((int)blockIdx.x % 8) * (F.G / 8) + (int)blockIdx.x / 8 : (int)blockIdx.x;
    const abf* FQ = (const abf*)(F.ws + WS_FQ); const abf* FK = (const abf*)(F.ws + WS_FK); const abf* FV = (const abf*)(F.ws + WS_FV); const abf* FOG = (const abf*)(F.ws + WS_FOG);
    const abf* DQ = (const abf*)(F.ws + WS_DQ); const abf* DK = (const abf*)(F.ws + WS_DK); const abf* DV = (const abf*)(F.ws + WS_DV);
    const float* CB = (const float*)(F.ws + WS_CB); abf* MG = (abf*)(F.ws + WS_MERGED);
    abf* O1 = (abf*)(F.ws + WS_O1); abf* O4 = (abf*)(F.ws + WS_O4); float* L1 = (float*)(F.ws + WS_LSEA); float* L4 = (float*)(F.ws + WS_LSEB);
    for (int v = vcu; v < 256; v += F.G) {
        const int bh = v >> 2, s = v & 3, b = bh >> 3, h = bh & 7;
#pragma unroll 1
        for (int i = 0; i < 4; ++i) { const int qb = (i == 0) ? s : (i == 1) ? 7 - s : (i == 2) ? 8 + s : 15 - s;
#ifndef NOFOX
            attn_body::dil_unit<0>(b, h, 1, 0, qb, FQ, FK, FV, nullptr, nullptr, nullptr, nullptr, nullptr, nullptr, MG, FOG, CB, lds);
#endif
        }
#pragma unroll 1
        for (int i = 0; i < 8; ++i) { const bool p4 = i >= 4;

#ifndef NODIL0
            attn_body::dil_unit<1>(b, h, p4 ? 4 : 1, p4 ? s : 0, p4 ? i - 4 : 4 * s + i, DQ, DK, DV, p4 ? O4 : O1, p4 ? L4 : L1, nullptr, nullptr, nullptr, nullptr, nullptr, nullptr, nullptr, lds);
#endif
        }
    }
}
__device__ __forceinline__ void p4_attn(Frame& F, char* lds) {
    typedef attn_body::bf16 abf;
    const int vcu = (F.G % 8 == 0) ? ((int)blockIdx.x % 8) * (F.G / 8) + (int)blockIdx.x / 8 : (int)blockIdx.x;
    const abf* DQ = (const abf*)(F.ws + WS_DQ); const abf* DK = (const abf*)(F.ws + WS_DK); const abf* DV = (const abf*)(F.ws + WS_DV); abf* MG = (abf*)(F.ws + WS_MERGED);
    const abf* O1 = (const abf*)(F.ws + WS_O1); const abf* O4 = (const abf*)(F.ws + WS_O4); const float* L1 = (const float*)(F.ws + WS_LSEA); const float* L4 = (const float*)(F.ws + WS_LSEB);
    for (int v = vcu; v < 256; v += F.G) {
        const int bh = v >> 2, s = v & 3, b = bh >> 3, h = bh & 7;
#pragma unroll 1
        for (int i = 0; i < 4; ++i) {
#ifndef NODIL1
            attn_body::dil_unit<2>(b, h, 16, 4 * s + i, 0, DQ, DK, DV, nullptr, nullptr, O1, L1, O4, L4, MG, nullptr, nullptr, lds);
#endif
        }
    }
}
}

namespace mk {
__global__ void __launch_bounds__(NWAVES * 64, 2) mk_fwd(Args args) {
    extern __shared__ __attribute__((aligned(16))) unsigned char lds[];
    Frame F;
    F.lds = (LAS unsigned char*)lds; F.lc = (LAS int*)(F.lds + LDSCTL_OFF);
    F.tid = threadIdx.x; F.lane = F.tid & 63; F.wave = __builtin_amdgcn_readfirstlane(F.tid >> 6);
    F.G = gridDim.x; F.gw = blockIdx.x * NWAVES + F.wave; F.NGW = F.G * NWAVES;
    F.x = (const float*)args.in[0]; F.c = (const float*)args.in[1]; F.pos = (const int*)args.in[2]; F.w_ada = (const float*)args.in[3]; F.b_ada = (const float*)args.in[4];
    F.w_in = (const float*)args.in[5]; F.b_forget = (const float*)args.in[6]; F.w_out = (const float*)args.in[7]; F.ln1_g = (const float*)args.in[8]; F.ln1_b = (const float*)args.in[9];
    F.w_rg = (const float*)args.in[10]; F.b_rg = (const float*)args.in[11]; F.w_re = (const float*)args.in[12]; F.b_re = (const float*)args.in[13];
    F.w_up = (const float*)args.in[14]; F.w_gate = (const float*)args.in[15]; F.w_down = (const float*)args.in[16]; F.ln2_g = (const float*)args.in[17]; F.ln2_b = (const float*)args.in[18];
    F.out = args.out; F.ws = args.ws;
    for (int u = F.tid; u < (LDS_BYTES - LDSCTL_OFF) / 4; u += NWAVES * 64) F.lc[u] = 0;
    __syncthreads();
    unsigned* ctl = (unsigned*)(F.ws + WS_CTL);
    XcdBarrier bar = xcd_barrier_post(ctl + CW_BAR + args.li * XCD_BAR_WORDS, (volatile LAS unsigned*)(F.lc + LC_BAR));
    const int lo = args.ph_lo, hi = args.ph_hi;
#define IN(k) (lo <= (k) && (k) < hi)
#define SEAM(k) do { if (IN(k) && IN((k) + 1)) xcd_barrier(bar); } while (0)

    if (IN(0)) { p0_prologue(F); } SEAM(0);
    if (IN(1)) { p1_hpass(F); } SEAM(1);
    if (IN(2)) {
        p2_cum(F);
        pg8::DenseSched S; S.A = (const bf16_t*)(F.ws + WS_H); S.Bt = (const bf16_t*)(F.ws + WS_WIN); S.K = D; S.so.init(M, NPROJ, F.G, (int)blockIdx.x);
        EpiProj E{(bf16_t*)(F.ws + WS_FQ), (const float*)(F.ws + WS_CS)};
        pg8::gemm_phase<EpiProj, pg8::DenseSched, true>(F.lds + RING_OFF, D, S, E);
    } SEAM(2);
    if (IN(3)) { p3_attn(F, (char*)lds + RING_OFF); } SEAM(3);
    if (IN(4)) { p4_attn(F, (char*)lds + RING_OFF); } SEAM(4);
    if (IN(5)) {
        pg8::DenseSched S; S.A = (const bf16_t*)(F.ws + WS_MERGED); S.Bt = (const bf16_t*)(F.ws + WS_WOUT); S.K = D; S.so.init(M, D, F.G, (int)blockIdx.x);
        EpiF32 E{(float*)(F.ws + WS_FQ), D};
        pg8::gemm_phase<EpiF32, pg8::DenseSched, true>(F.lds + RING_OFF, D, S, E);
    } SEAM(5);
    if (IN(6)) { p6_ln1_router(F); } SEAM(6);
    if (IN(7)) {
        moe_offsets(F);
        pg8::MoeSched<true> S; S.A = (const bf16_t*)(F.ws + WS_H); S.Bt = (const bf16_t*)(F.ws + WS_WGU); S.K = D; S.estride = (size_t)1024 * 1024 * 2; S.NT = 4; S.G = F.G; S.c = (int)blockIdx.x;
        S.poff = F.lc + LC_POFF; S.tl = (const LAS int*)(F.lds + TL_OFF);
        { LAS int* tl = (LAS int*)(F.lds + TL_OFF); const int* list = (const int*)(F.ws + WS_LIST); Unit u;
          for (int i = 0; i < 8 && S.next(i, u); ++i) if (F.tid < 256) { const int idx = u.pm * 256 - F.lc[LC_POFF + u.e] + F.tid; tl[i * 256 + F.tid] = (idx < F.lc[LC_CNT + u.e]) ? list[(size_t)u.e * LCAP + idx] : 0; }
          __syncthreads(); }
        EpiSwiglu E{(bf16_t*)(F.ws + WS_ACT)};
        pg8::gemm_phase<EpiSwiglu, pg8::MoeSched<true>, true>(F.lds + RING_OFF, D, S, E);
    } SEAM(7);
    if (IN(8)) {
        moe_offsets(F);
        pg8::MoeSched<false> S; S.A = (const bf16_t*)(F.ws + WS_ACT); S.Bt = (const bf16_t*)(F.ws + WS_WD); S.K = DE; S.estride = (size_t)1024 * 512 * 2; S.NT = 4; S.G = F.G; S.c = (int)blockIdx.x;
        S.poff = F.lc + LC_POFF; S.tl = nullptr;
        EpiBf16 E{(bf16_t*)(F.ws + WS_Y), D};
        pg8::gemm_phase<EpiBf16, pg8::MoeSched<false>, true>(F.lds + RING_OFF, DE, S, E);
    } SEAM(8);
    if (IN(9)) { moe_offsets(F); p9_final(F); }
#undef IN
#undef SEAM
}
}

extern "C" void kernel_launch(void* const* d_in, const int* in_sizes, int n_in, void* d_out, int out_size, void* d_ws, size_t ws_size, hipStream_t stream) {
    using namespace mk;
    static int grid = 0;
    if (grid == 0) {
        if (n_in != 19 || out_size != M * D || ws_size < WS_END) { fprintf(stderr, "kernel_launch: unexpected shapes / workspace (%d inputs, out %d, ws %zu)\n", n_in, out_size, ws_size); grid = -1; return; }
        int dev = 0, cus = 0, per_cu = 0;
        if (hipGetDevice(&dev) != hipSuccess || hipDeviceGetAttribute(&cus, hipDeviceAttributeMultiprocessorCount, dev) != hipSuccess) { grid = -1; return; }
        if (hipFuncSetAttribute((const void*)mk_fwd, hipFuncAttributeMaxDynamicSharedMemorySize, LDS_BYTES) != hipSuccess) { grid = -1; return; }
        if (hipOccupancyMaxActiveBlocksPerMultiprocessor(&per_cu, (const void*)mk_fwd, NWAVES * 64, LDS_BYTES) != hipSuccess || per_cu < 1) { fprintf(stderr, "kernel_launch: occupancy query says %d\n", per_cu); }
        (void)hipGetLastError();
        grid = cus;
    }
    if (grid < 0) return;
    (void)hipMemsetAsync((char*)d_ws + WS_CTL, 0, 1u << 20, stream);
    Args a{};
    for (int i = 0; i < 19; ++i) a.in[i] = d_in[i];
    a.out = (float*)d_out; a.ws = (unsigned char*)d_ws;
#if MIX_GOLD_ATTN
    unsigned char* ws = (unsigned char*)d_ws;
    a.ph_lo = 0; a.ph_hi = 3; a.li = 0;
    hipLaunchKernelGGL(mk_fwd, dim3(grid), dim3(NWAVES * 64), LDS_BYTES, stream, a);
    gold::k_fox<<<dim3(S / 256, 64), 256, 0, stream>>>((bf16_t*)(ws + WS_FQ), (bf16_t*)(ws + WS_FK), (bf16_t*)(ws + WS_FV), (bf16_t*)(ws + WS_FOG), (float*)(ws + WS_CB), (bf16_t*)(ws + WS_MERGED));
    gold::k_dil<<<dim3(S / 256, 64), 256, 0, stream>>>((bf16_t*)(ws + WS_DQ), (bf16_t*)(ws + WS_DK), (bf16_t*)(ws + WS_DV), (bf16_t*)(ws + WS_MERGED));
    a.ph_lo = 5; a.ph_hi = 10; a.li = 1;
    hipLaunchKernelGGL(mk_fwd, dim3(grid), dim3(NWAVES * 64), LDS_BYTES, stream, a);
#else
    a.ph_lo = 0; a.ph_hi = 10; a.li = 0;
    hipLaunchKernelGGL(mk_fwd, dim3(grid), dim3(NWAVES * 64), LDS_BYTES, stream, a);
#endif
}
```
